# Optimizing an MI355X kernel written in HIP

```python
import math
import jax, jax.numpy as jnp
from jax import lax
import numpy as np

D_MODEL = 1024
BATCH = 16
SEQ = 2048
DEPTH = 4

N_A_LAYERS = DEPTH // 2
N_B_LAYERS = DEPTH - N_A_LAYERS
PLE_DIM = 256
SSM_DIM = D_MODEL
SSM_GROUP_DIM = 16
SSM_GROUPS = SSM_DIM // SSM_GROUP_DIM
SSM_STATE = 64
SSM_CHUNK = 128
N_HEADS = 8
HEAD_DIM = 64
Q_BLOCK = 128
REL_BUCKETS = 32
REL_MAX_EXACT = REL_BUCKETS // 2
REL_MAX_DIST = 128
D_FF = 2816
CONV_WIDTH = 3
NEG_INF = -1e30
EPS = 1e-6

kernel_name = "yoco_s5_diffattn_convffn_hybrid"


def rms_norm(x, g):
    xf = x.astype(jnp.float32)
    y = xf * lax.rsqrt(jnp.mean(xf * xf, axis=-1, keepdims=True) + EPS)
    return (y * g.astype(jnp.float32)).astype(x.dtype)


def _ssm_combine(e_i, e_j):
    ar_i, ai_i, br_i, bi_i = e_i
    ar_j, ai_j, br_j, bi_j = e_j
    return (ar_j * ar_i - ai_j * ai_i,
            ar_j * ai_i + ai_j * ar_i,
            ar_j * br_i - ai_j * bi_i + br_j,
            ar_j * bi_i + ai_j * br_i + bi_j)


def s5_mixer(h, w_in, log_dt, lam_re, lam_im, b_re, b_im, c_re, c_im, d_skip, w_glu):
    f32 = jnp.float32
    bsz, seqlen, _ = h.shape
    u = h @ w_in
    dt = jnp.exp(log_dt.astype(f32))[:, None]
    lr = lam_re.astype(f32)
    li = lam_im.astype(f32)
    mag = jnp.exp(lr * dt)
    ab_r = mag * jnp.cos(li * dt)
    ab_i = mag * jnp.sin(li * dt)
    den = lr * lr + li * li
    f_r = ((ab_r - 1.0) * lr + ab_i * li) / den
    f_i = (ab_i * lr - (ab_r - 1.0) * li) / den
    br = b_re.astype(f32)
    bi = b_im.astype(f32)
    bb_r = f_r[..., None] * br - f_i[..., None] * bi
    bb_i = f_r[..., None] * bi + f_i[..., None] * br
    cr = c_re.astype(f32)
    ci = c_im.astype(f32)
    n_chunks = seqlen // SSM_CHUNK
    uc = u.astype(f32).reshape(bsz, n_chunks, SSM_CHUNK, SSM_GROUPS, SSM_GROUP_DIM)
    uc = uc.transpose(1, 2, 0, 3, 4)
    a_shape = (SSM_CHUNK, bsz, SSM_GROUPS, SSM_STATE)
    a_r = jnp.broadcast_to(ab_r, a_shape)
    a_i = jnp.broadcast_to(ab_i, a_shape)

    def chunk_step(carry, u_chunk):
        x_r0, x_i0 = carry
        bu_r = jnp.einsum("tbgc,gpc->tbgp", u_chunk, bb_r)
        bu_i = jnp.einsum("tbgc,gpc->tbgp", u_chunk, bb_i)
        pw_r, pw_i, s_r, s_i = lax.associative_scan(
            _ssm_combine, (a_r, a_i, bu_r, bu_i), axis=0)
        x_r = s_r + pw_r * x_r0 - pw_i * x_i0
        x_i = s_i + pw_r * x_i0 + pw_i * x_r0
        y = (jnp.einsum("tbgp,gcp->tbgc", x_r, cr)
             - jnp.einsum("tbgp,gcp->tbgc", x_i, ci))
        return (x_r[-1], x_i[-1]), y

    zeros = jnp.zeros((bsz, SSM_GROUPS, SSM_STATE), f32)
    _, ys = lax.scan(chunk_step, (zeros, zeros), uc)
    y = ys.transpose(2, 0, 1, 3, 4).reshape(bsz, seqlen, SSM_DIM)
    y = y + d_skip.astype(f32) * u.astype(f32)
    g = jax.nn.gelu(y).astype(h.dtype)
    val, gate = jnp.split(g @ w_glu, 2, axis=-1)
    return val * jax.nn.sigmoid(gate)


def t5_causal_bucket(rel):
    n = jnp.maximum(-rel, 0)
    nf = jnp.maximum(n, REL_MAX_EXACT).astype(jnp.float32)
    large = REL_MAX_EXACT + (jnp.log(nf / REL_MAX_EXACT)
                             / math.log(REL_MAX_DIST / REL_MAX_EXACT)
                             * (REL_BUCKETS - REL_MAX_EXACT)).astype(jnp.int32)
    large = jnp.minimum(large, REL_BUCKETS - 1)
    return jnp.where(n < REL_MAX_EXACT, n, large)


def shared_kv(x, kv_norm, kv_w, k_norm):
    bsz, seqlen, _ = x.shape
    kv = rms_norm(x, kv_norm) @ kv_w
    nk = 2 * N_HEADS * HEAD_DIM
    k = rms_norm(kv[..., :nk].reshape(bsz, seqlen, N_HEADS, 2, HEAD_DIM), k_norm)
    v = kv[..., nk:].reshape(bsz, seqlen, N_HEADS, 2 * HEAD_DIM)
    return k, v


def diff_attention(h, k, v, rel_bias, w_q, q_norm, lq1, lk1, lq2, lk2, subln, w_o, lam_init):
    f32 = jnp.float32
    bsz, seqlen, _ = h.shape
    q = rms_norm((h @ w_q).reshape(bsz, seqlen, N_HEADS, 2, HEAD_DIM), q_norm)
    lam = (jnp.exp(jnp.sum(lq1.astype(f32) * lk1.astype(f32)))
           - jnp.exp(jnp.sum(lq2.astype(f32) * lk2.astype(f32))) + lam_init)
    scale = HEAD_DIM ** -0.5
    n_blocks = seqlen // Q_BLOCK
    qb = q.reshape(bsz, n_blocks, Q_BLOCK, N_HEADS, 2, HEAD_DIM).transpose(1, 0, 2, 3, 4, 5)
    k_pos = jnp.arange(seqlen)

    def block(args):
        idx, qc = args
        q_pos = idx * Q_BLOCK + jnp.arange(Q_BLOCK)
        rel = k_pos[None, :] - q_pos[:, None]
        bias = rel_bias[t5_causal_bucket(rel)].astype(f32).transpose(2, 0, 1)
        s = jnp.einsum("bqhcd,bkhcd->bhcqk", qc, k).astype(f32) * scale
        s = s + bias[None, :, None]
        s = jnp.where(rel <= 0, s, NEG_INF)
        pm = jax.nn.softmax(s, axis=-1)
        attn = pm[:, :, 0] - lam * pm[:, :, 1]
        return jnp.einsum("bhqk,bkhe->bqhe", attn.astype(v.dtype), v)

    o = lax.map(block, (jnp.arange(n_blocks), qb))
    o = o.transpose(1, 0, 2, 3, 4).reshape(bsz, seqlen, N_HEADS, 2 * HEAD_DIM)
    o = rms_norm(o, subln) * (1.0 - lam_init)
    return o.reshape(bsz, seqlen, N_HEADS * 2 * HEAD_DIM) @ w_o


def conv_ffn(h, w_up, conv_w, conv_b, w_down):
    up = h @ w_up
    seqlen = up.shape[1]
    padded = jnp.pad(up, ((0, 0), (CONV_WIDTH - 1, 0), (0, 0)))
    c = conv_b
    for j in range(CONV_WIDTH):
        c = c + conv_w[j] * padded[:, j:j + seqlen]
    g, val = jnp.split(c, 2, axis=-1)
    return (jax.nn.gelu(g) * val) @ w_down


def setup_inputs(seed: int = 0) -> dict:
    key = jax.random.key(seed)
    ks = iter(jax.random.split(key, 40))
    f32 = jnp.float32

    def nrm(shape, scale):
        return jax.random.normal(next(ks), shape, f32) * scale

    def gain(shape):
        return 1.0 + nrm(shape, 0.05)

    na, nb = N_A_LAYERS, N_B_LAYERS
    lam_im = jnp.pi * jnp.arange(SSM_STATE, dtype=f32)
    return {
        "x": nrm((BATCH, SEQ, D_MODEL), 1.0),
        "p": nrm((DEPTH, BATCH, SEQ, PLE_DIM), 1.0),
        "ssm_norm": gain((na, D_MODEL)),
        "ssm_w_in": nrm((na, D_MODEL, SSM_DIM), D_MODEL ** -0.5),
        "ssm_log_dt": jax.random.uniform(next(ks), (na, SSM_GROUPS), f32,
                                         math.log(1e-3), math.log(1e-1)),
        "ssm_lambda_re": -0.5 + nrm((na, SSM_GROUPS, SSM_STATE), 0.01),
        "ssm_lambda_im": lam_im + nrm((na, SSM_GROUPS, SSM_STATE), 0.01),
        "ssm_b_re": nrm((na, SSM_GROUPS, SSM_STATE, SSM_GROUP_DIM), SSM_GROUP_DIM ** -0.5),
        "ssm_b_im": nrm((na, SSM_GROUPS, SSM_STATE, SSM_GROUP_DIM), SSM_GROUP_DIM ** -0.5),
        "ssm_c_re": nrm((na, SSM_GROUPS, SSM_GROUP_DIM, SSM_STATE), SSM_STATE ** -0.5),
        "ssm_c_im": nrm((na, SSM_GROUPS, SSM_GROUP_DIM, SSM_STATE), SSM_STATE ** -0.5),
        "ssm_d": nrm((na, SSM_DIM), 0.5),
        "ssm_w_glu": nrm((na, SSM_DIM, 2 * D_MODEL), SSM_DIM ** -0.5),
        "kv_norm": gain((D_MODEL,)),
        "kv_w": nrm((D_MODEL, 2 * N_HEADS * HEAD_DIM + N_HEADS * 2 * HEAD_DIM), D_MODEL ** -0.5),
        "k_norm": gain((HEAD_DIM,)),
        "attn_norm": gain((nb, D_MODEL)),
        "attn_w_q": nrm((nb, D_MODEL, 2 * N_HEADS * HEAD_DIM), D_MODEL ** -0.5),
        "q_norm": gain((nb, HEAD_DIM)),
        "lambda_q1": nrm((nb, HEAD_DIM), 0.1),
        "lambda_k1": nrm((nb, HEAD_DIM), 0.1),
        "lambda_q2": nrm((nb, HEAD_DIM), 0.1),
        "lambda_k2": nrm((nb, HEAD_DIM), 0.1),
        "subln": gain((nb, 2 * HEAD_DIM)),
        "attn_w_o": nrm((nb, N_HEADS * 2 * HEAD_DIM, D_MODEL), (N_HEADS * 2 * HEAD_DIM) ** -0.5),
        "rel_bias": nrm((REL_BUCKETS, N_HEADS), 0.5),
        "ffn_norm": gain((DEPTH, D_MODEL)),
        "ffn_w_up": nrm((DEPTH, D_MODEL, 2 * D_FF), D_MODEL ** -0.5),
        "ffn_conv_w": nrm((DEPTH, CONV_WIDTH, 2 * D_FF), CONV_WIDTH ** -0.5),
        "ffn_conv_b": nrm((DEPTH, 2 * D_FF), 0.02),
        "ffn_w_down": nrm((DEPTH, D_FF, D_MODEL), D_FF ** -0.5),
        "ple_norm": gain((DEPTH, D_MODEL)),
        "ple_w_gate": nrm((DEPTH, D_MODEL, D_MODEL), D_MODEL ** -0.5),
        "ple_w_proj": nrm((DEPTH, PLE_DIM, D_MODEL), PLE_DIM ** -0.5),
    }


def reference(x, p, ssm_norm, ssm_w_in, ssm_log_dt, ssm_lambda_re, ssm_lambda_im,
              ssm_b_re, ssm_b_im, ssm_c_re, ssm_c_im, ssm_d, ssm_w_glu,
              kv_norm, kv_w, k_norm, attn_norm, attn_w_q, q_norm,
              lambda_q1, lambda_k1, lambda_q2, lambda_k2, subln, attn_w_o, rel_bias,
              ffn_norm, ffn_w_up, ffn_conv_w, ffn_conv_b, ffn_w_down,
              ple_norm, ple_w_gate, ple_w_proj):
    k = v = None
    for i in range(DEPTH):
        if i < N_A_LAYERS:
            h = rms_norm(x, ssm_norm[i])
            x = x + s5_mixer(h, ssm_w_in[i], ssm_log_dt[i], ssm_lambda_re[i], ssm_lambda_im[i],
                             ssm_b_re[i], ssm_b_im[i], ssm_c_re[i], ssm_c_im[i],
                             ssm_d[i], ssm_w_glu[i])
        else:
            if i == N_A_LAYERS:
                k, v = shared_kv(x, kv_norm, kv_w, k_norm)
            j = i - N_A_LAYERS
            lam_init = 0.8 - 0.6 * math.exp(-0.3 * i)
            h = rms_norm(x, attn_norm[j])
            x = x + diff_attention(h, k, v, rel_bias, attn_w_q[j], q_norm[j],
                                   lambda_q1[j], lambda_k1[j], lambda_q2[j], lambda_k2[j],
                                   subln[j], attn_w_o[j], lam_init)
        h = rms_norm(x, ffn_norm[i])
        x = x + conv_ffn(h, ffn_w_up[i], ffn_conv_w[i], ffn_conv_b[i], ffn_w_down[i])
        gate = jax.nn.sigmoid(rms_norm(x, ple_norm[i]) @ ple_w_gate[i])
        x = x + gate * (p[i] @ ple_w_proj[i])
    return x
```

```cpp
#include <hip/hip_runtime.h>
#include <hip/hip_cooperative_groups.h>
#include <stdint.h>
#include <stdio.h>
#include <string.h>
namespace cg = cooperative_groups;

typedef unsigned short bf16_t;
typedef short bf16x8 __attribute__((ext_vector_type(8)));
typedef float f32x4 __attribute__((ext_vector_type(4)));
typedef unsigned int u32x4 __attribute__((ext_vector_type(4)));
typedef unsigned int u32x2 __attribute__((ext_vector_type(2)));

#ifndef MK_SINGLE
#define MK_SINGLE 0
#endif

#define EPSF 1e-6f
#define MIB (1ull << 20)
#define OFF_WIN  (0 * MIB)
#define OFF_WGLU (2 * MIB)
#define OFF_PT   (6 * MIB)
#define OFF_YT   (10 * MIB)
#define OFF_WKVQ (0 * MIB)
#define OFF_WO   (6 * MIB)
#define OFF_WUP  (22 * MIB)
#define OFF_WDN  (33 * MIB)
#define OFF_WGT  (39 * MIB)
#define OFF_WPJ  (41 * MIB)
#define OFF_SMALL (42 * MIB)
#define OFF_XB   (43 * MIB)
#define OFF_UG   (107 * MIB)
#define OFF_S    (171 * MIB)
#define OFF_XC   (235 * MIB)
#define OFF_GY   (267 * MIB)
#define OFF_K    (107 * MIB)
#define OFF_VT   (171 * MIB)
#define OFF_QO   (235 * MIB)
#define OFF_ACT  (235 * MIB)
#define OFF_HALO (411 * MIB)
#define WS_NEED  (422 * MIB)

struct Params {
  const float* in[34];
  float* out;
  char* ws;
  int ph_lo, ph_hi, coop, pad;
};

__device__ __forceinline__ bf16_t f2bf(float f) {
  uint32_t u = __float_as_uint(f);
  u += 0x7fffu + ((u >> 16) & 1u);
  return (bf16_t)(u >> 16);
}
__device__ __forceinline__ float bf2f(bf16_t h) { return __uint_as_float(((uint32_t)h) << 16); }
__device__ __forceinline__ uint32_t pack2(float a, float b) { return (uint32_t)f2bf(a) | ((uint32_t)f2bf(b) << 16); }
__device__ __forceinline__ float bflo(uint32_t u) { return __uint_as_float(u << 16); }
__device__ __forceinline__ float bfhi(uint32_t u) { return __uint_as_float(u & 0xffff0000u); }
__device__ __forceinline__ float gelu_t(float x) {
  float z = 0.7978845608f * (x + 0.044715f * x * x * x);
  return x / (1.f + __expf(-2.f * z));
}
__device__ __forceinline__ float sigm(float x) { return 1.f / (1.f + __expf(-x)); }
__device__ __forceinline__ float sumsq8(u32x4 v) {
  float a0 = bflo(v.x), a1 = bfhi(v.x), a2 = bflo(v.y), a3 = bfhi(v.y);
  float a4 = bflo(v.z), a5 = bfhi(v.z), a6 = bflo(v.w), a7 = bfhi(v.w);
  return (a0 * a0 + a1 * a1) + (a2 * a2 + a3 * a3) + (a4 * a4 + a5 * a5) + (a6 * a6 + a7 * a7);
}

struct ALBf {
  const bf16_t* A; int lda;
  __device__ __forceinline__ u32x4 operator()(int row, int k) const { return *(const u32x4*)(A + (size_t)row * lda + k); }
};
struct ALF32 {
  const float* A; int lda;
  __device__ __forceinline__ u32x4 operator()(int row, int k) const {
    const f32x4* p = (const f32x4*)(A + (size_t)row * lda + k);
    const f32x4 a = p[0], b = p[1];
    u32x4 r; r.x = pack2(a.x, a.y); r.y = pack2(a.z, a.w); r.z = pack2(b.x, b.y); r.w = pack2(b.z, b.w); return r;
  }
};
struct ALHalo {
  const bf16_t* A;
  __device__ __forceinline__ u32x4 operator()(int row, int k) const {
    int tok = 128 * (row >> 1) - 2 + (row & 1); tok = tok < 0 ? 0 : tok;
    return *(const u32x4*)(A + (size_t)tok * 1024 + k);
  }
};
struct ALSsmY {
  const bf16_t* ugg; const bf16_t* xcg;
  __device__ __forceinline__ u32x4 operator()(int row, int k) const {
    if (k < 256) return *(const u32x4*)(ugg + (size_t)row * 256 + k);
    return *(const u32x4*)(xcg + (size_t)row * 8192 + (k - 256));
  }
};

template <class AL, bool SS>
__device__ __forceinline__ void kloop(f32x4 (&acc)[4][4], const AL& al, const bf16_t* __restrict__ Bt, int ldb,
                                      int m0, int n0, int K, bf16_t* sm) {
  int tid_ = threadIdx.x; asm volatile("" : "+v"(tid_));
  const int tid = tid_, lane = tid & 63, wid = tid >> 6, wr = wid >> 1, wc = wid & 1;
  const int lrow = tid >> 3, lkv = tid & 7;
  const int lq = lane >> 4, lr = lane & 15;
  float ssq[4] = {0.f, 0.f, 0.f, 0.f};
  u32x4 ra[4], rb[4];
  const int nk = K >> 6;
  const int wofs = (lkv >> 2) * 4096 + lrow * 32 + (lkv & 3) * 8;
  const bf16_t* bp = Bt + (size_t)(n0 + lrow) * ldb + lkv * 8;
  __syncthreads();
#pragma unroll
  for (int i = 0; i < 4; ++i) { ra[i] = al(m0 + lrow + 32 * i, lkv * 8); rb[i] = *(const u32x4*)(bp + (size_t)(32 * i) * ldb); }
  for (int kt = 0; kt < nk; ++kt) {
    bf16_t* sA = sm + (kt & 1) * 8192;
    bf16_t* sB = sm + 16384 + (kt & 1) * 8192;
#pragma unroll
    for (int i = 0; i < 4; ++i) {
      *(u32x4*)(sA + wofs + i * 1024) = ra[i];
      *(u32x4*)(sB + wofs + i * 1024) = rb[i];
      if (SS) ssq[i] += sumsq8(ra[i]);
    }
    __syncthreads();
    if (kt + 1 < nk) {
      const int k1 = (kt + 1) * 64 + lkv * 8;
#pragma unroll
      for (int i = 0; i < 4; ++i) { ra[i] = al(m0 + lrow + 32 * i, k1); rb[i] = *(const u32x4*)(bp + (size_t)(32 * i) * ldb + (kt + 1) * 64); }
    }
#pragma unroll
    for (int ks = 0; ks < 2; ++ks) {
      bf16x8 af[4], bfr[4];
#pragma unroll
      for (int m = 0; m < 4; ++m) af[m] = *(const bf16x8*)(sA + ks * 4096 + (wr * 64 + m * 16 + lr) * 32 + lq * 8);
#pragma unroll
      for (int n = 0; n < 4; ++n) bfr[n] = *(const bf16x8*)(sB + ks * 4096 + (wc * 64 + n * 16 + lr) * 32 + lq * 8);
#pragma unroll
      for (int m = 0; m < 4; ++m)
#pragma unroll
        for (int n = 0; n < 4; ++n) acc[m][n] = __builtin_amdgcn_mfma_f32_16x16x32_bf16(bfr[n], af[m], acc[m][n], 0, 0, 0);
    }
  }
  __syncthreads();
  if (SS) {
#pragma unroll
    for (int i = 0; i < 4; ++i) {
      float s = ssq[i];
      s += __shfl_xor(s, 1); s += __shfl_xor(s, 2); s += __shfl_xor(s, 4);
      if (lkv == 0) ((float*)sm)[lrow + 32 * i] = s;
    }
    __syncthreads();
  }
}

__device__ __forceinline__ void zero_acc(f32x4 (&acc)[4][4]) {
#pragma unroll
  for (int m = 0; m < 4; ++m)
#pragma unroll
    for (int n = 0; n < 4; ++n) acc[m][n] = (f32x4){0.f, 0.f, 0.f, 0.f};
}

__device__ __forceinline__ int srccol(int n, int mode) {
  if (mode == 1) { int q = n >> 5, i = n & 31; return i < 16 ? 16 * q + i : 1024 + 16 * q + (i - 16); }
  if (mode == 2) { int nt = n >> 7, j = n & 127; return j < 64 ? nt * 64 + j : 2816 + nt * 64 + (j - 64); }
  return n;
}
__device__ __forceinline__ void prep_mat(const float* __restrict__ src, int K, int N, int Nsub, bf16_t* __restrict__ dst, const float* __restrict__ gain, int mode, float* smf) {
  int tid_ = threadIdx.x; asm volatile("" : "+v"(tid_)); const int tid = tid_;
  const int KT = K >> 6, NT = Nsub >> 6;
  for (int t = blockIdx.x; t < KT * NT; t += gridDim.x) {
    const int k0 = (t % KT) * 64, n0 = (t / KT) * 64;
    __syncthreads();
    {
      const int j = tid & 63; const int sc = srccol(n0 + j, mode);
#pragma unroll
      for (int i = 0; i < 16; ++i) {
        const int k = i * 4 + (tid >> 6);
        float v = src[(size_t)(k0 + k) * N + sc];
        if (gain) v *= gain[k0 + k];
        smf[k * 65 + j] = v;
      }
    }
    __syncthreads();
#pragma unroll
    for (int i = 0; i < 2; ++i) {
      const int row = (tid >> 3) + 32 * i, kv = tid & 7;
      float v[8];
#pragma unroll
      for (int e = 0; e < 8; ++e) v[e] = smf[(kv * 8 + e) * 65 + row];
      u32x4 o; o.x = pack2(v[0], v[1]); o.y = pack2(v[2], v[3]); o.z = pack2(v[4], v[5]); o.w = pack2(v[6], v[7]);
      *(u32x4*)(dst + (size_t)(n0 + row) * K + k0 + kv * 8) = o;
    }
  }
}

__device__ __forceinline__ void prep_ssm(const float* log_dt, const float* lam_re, const float* lam_im, const float* b_re, const float* b_im,
                         const float* c_re, const float* c_im, bf16_t* PT, bf16_t* YT, float* a16, float* smf) {
  int tid_ = threadIdx.x; asm volatile("" : "+v"(tid_)); const int tid = tid_;
  float* s_abr = smf; float* s_abi = smf + 64; float* s_fr = smf + 128; float* s_fi = smf + 192;
  for (int g = blockIdx.x; g < 64; g += gridDim.x) {
    __syncthreads();
    if (tid < 64) {
      const int p = tid;
      const float dt = expf(log_dt[g]);
      const float lr = lam_re[g * 64 + p], li = lam_im[g * 64 + p];
      const float mag = expf(lr * dt);
      const float abr = mag * cosf(li * dt), abi = mag * sinf(li * dt);
      const float den = lr * lr + li * li;
      const float fr = ((abr - 1.f) * lr + abi * li) / den;
      const float fi = (abi * lr - (abr - 1.f) * li) / den;
      s_abr[p] = abr; s_abi[p] = abi; s_fr[p] = fr; s_fi[p] = fi;
      float xr = abr, xi = abi;
#pragma unroll
      for (int q = 0; q < 4; ++q) { float nr = xr * xr - xi * xi, ni = 2.f * xr * xi; xr = nr; xi = ni; }
      a16[(g * 64 + p) * 2] = xr; a16[(g * 64 + p) * 2 + 1] = xi;
    }
    __syncthreads();
    {
      float* s_pr = smf + 256; float* s_pi = smf + 320;
      const int co = tid >> 4, ci = tid & 15;
      bf16_t* yg = YT + (size_t)g * 256 * 384;
      if (tid < 64) { s_pr[tid] = 1.f; s_pi[tid] = 0.f; }
      __syncthreads();
#pragma unroll 1
      for (int j = 0; j < 16; ++j) {
        float kj = 0.f;
#pragma unroll 4
        for (int p = 0; p < 64; ++p) {
          const float br = b_re[(g * 64 + p) * 16 + ci], bi = b_im[(g * 64 + p) * 16 + ci];
          const float fr = s_fr[p], fi = s_fi[p];
          const float bbr = fr * br - fi * bi, bbi = fr * bi + fi * br;
          const float cr = c_re[(g * 16 + co) * 64 + p], cim = c_im[(g * 16 + co) * 64 + p];
          const float zr = cr * bbr - cim * bbi, zi = cr * bbi + cim * bbr;
          kj += zr * s_pr[p] - zi * s_pi[p];
        }
        const bf16_t v = f2bf(kj);
#pragma unroll 1
        for (int t = j; t < 16; ++t) { const int s = t - j; yg[(t * 16 + co) * 384 + s * 16 + ci] = v; }
        if (j > 0) {
#pragma unroll 1
          for (int t = 0; t + j < 16; ++t) { const int s = t + j; yg[(t * 16 + co) * 384 + s * 16 + ci] = 0; }
        }
        __syncthreads();
        if (tid < 64) { const float pr = s_pr[tid], pi = s_pi[tid], ar = s_abr[tid], ai = s_abi[tid]; s_pr[tid] = pr * ar - pi * ai; s_pi[tid] = pr * ai + pi * ar; }
        __syncthreads();
      }
    }
    {
      bf16_t* yg = YT + (size_t)g * 256 * 384;
#pragma unroll 1
      for (int i = 0; i < 4; ++i) {
        const int idx = tid + 256 * i, co = idx >> 6, p = idx & 63;
        const float ar = s_abr[p], ai = s_abi[p];
        float zr = c_re[(g * 16 + co) * 64 + p], zi = c_im[(g * 16 + co) * 64 + p];
#pragma unroll 1
        for (int t = 0; t < 16; ++t) {
          const float nr = zr * ar - zi * ai, ni = zr * ai + zi * ar; zr = nr; zi = ni;
          yg[(t * 16 + co) * 384 + 256 + p] = f2bf(zr);
          yg[(t * 16 + co) * 384 + 320 + p] = f2bf(-zi);
        }
      }
    }
    {
      bf16_t* pg = PT + (size_t)g * 128 * 256;
#pragma unroll 1
      for (int i = 0; i < 4; ++i) {
        const int idx = tid + 256 * i, p = idx >> 4, c = idx & 15;
        const float ar = s_abr[p], ai = s_abi[p], fr = s_fr[p], fi = s_fi[p];
        const float br = b_re[(g * 64 + p) * 16 + c], bi = b_im[(g * 64 + p) * 16 + c];
        float zr = fr * br - fi * bi, zi = fr * bi + fi * br;
#pragma unroll 1
        for (int t = 15; t >= 0; --t) {
          pg[p * 256 + t * 16 + c] = f2bf(zr);
          pg[(64 + p) * 256 + t * 16 + c] = f2bf(zi);
          const float nr = zr * ar - zi * ai, ni = zr * ai + zi * ar; zr = nr; zi = ni;
        }
      }
    }
  }
}

__device__ __forceinline__ void prep_bias(const float* rel_bias, float* tab) {
  if (blockIdx.x == 0) {
    int tid_ = threadIdx.x; asm volatile("" : "+v"(tid_));
    for (int idx = tid_; idx < 8 * 129; idx += 256) {
      const int h = idx / 129, n = idx % 129;
      int bucket;
      if (n < 16) bucket = n;
      else {
        double nf = (double)n;
        int lg = 16 + (int)(log(nf / 16.0) / log(8.0) * 16.0);
        bucket = lg < 31 ? lg : 31;
      }
      tab[h * 132 + n] = rel_bias[bucket * 8 + h] * 1.4426950408889634f;
    }
  }
}

#define ROWL(m) (wr * 64 + (m) * 16 + lr)
#define COLL(n) (wc * 64 + (n) * 16 + lq * 4)
#define LANE_IDS int tid_ = threadIdx.x; asm volatile("" : "+v"(tid_)); const int tid = tid_, lane = tid & 63, wid = tid >> 6, wr = wid >> 1, wc = wid & 1, lq = lane >> 4, lr = lane & 15; (void)tid; (void)wr; (void)wc; (void)lq; (void)lr;

__device__ __forceinline__ void ph_win(const float* x, const bf16_t* WinT, bf16_t* ug, bf16_t* sm) {
  LANE_IDS
  ALF32 al{x, 1024};
  for (int t = blockIdx.x; t < 256 * 8; t += gridDim.x) {
    const int mt = t >> 3, nt = t & 7, m0 = mt * 128, n0 = nt * 128;
    f32x4 acc[4][4]; zero_acc(acc);
    kloop<ALF32, true>(acc, al, WinT, 1024, m0, n0, 1024, sm);
    const float* rs = (const float*)sm;
#pragma unroll
    for (int m = 0; m < 4; ++m) {
      const float rstd = rsqrtf(rs[ROWL(m)] * (1.f / 1024.f) + EPSF);
      const int tok = m0 + ROWL(m);
#pragma unroll
      for (int n = 0; n < 4; ++n) {
        const int g = (n0 + wc * 64 + n * 16) >> 4;
        const f32x4 v = acc[m][n] * rstd;
        u32x2 o; o.x = pack2(v[0], v[1]); o.y = pack2(v[2], v[3]);
        *(u32x2*)(ug + ((size_t)(g * 2048 + (tok >> 4)) * 256 + (tok & 15) * 16 + lq * 4)) = o;
      }
    }
  }
}

__device__ __forceinline__ void ph_sstate(const bf16_t* ug, const bf16_t* PT, float* S, bf16_t* sm) {
  LANE_IDS
  for (int t = blockIdx.x; t < 64 * 16; t += gridDim.x) {
    const int g = t >> 4, mt = t & 15, m0 = mt * 128;
    ALBf al{ug + (size_t)g * 2048 * 256, 256};
    f32x4 acc[4][4]; zero_acc(acc);
    kloop<ALBf, false>(acc, al, PT + (size_t)g * 128 * 256, 256, m0, 0, 256, sm);
#pragma unroll
    for (int m = 0; m < 4; ++m) {
      const int row = m0 + ROWL(m);
#pragma unroll
      for (int n = 0; n < 4; ++n) *(f32x4*)(S + ((size_t)row * 64 + g) * 128 + COLL(n)) = acc[m][n];
    }
  }
}

__device__ __forceinline__ void ph_scan(const float* S, const float* a16, bf16_t* Xc) {
  int tid_ = threadIdx.x; asm volatile("" : "+v"(tid_));
  for (int idx = blockIdx.x * 256 + tid_; idx < 16 * 64 * 64; idx += gridDim.x * 256) {
    const int p = idx & 63, g = (idx >> 6) & 63, b = idx >> 12;
    const float ar = a16[(g * 64 + p) * 2], ai = a16[(g * 64 + p) * 2 + 1];
    float xr = 0.f, xi = 0.f;
#pragma unroll 8
    for (int c = 0; c < 128; ++c) {
      const size_t off = ((size_t)(b * 128 + c) * 64 + g) * 128;
      Xc[off + p] = f2bf(xr); Xc[off + 64 + p] = f2bf(xi);
      const float sr = S[off + p], si = S[off + 64 + p];
      const float nr = ar * xr - ai * xi + sr, ni = ar * xi + ai * xr + si;
      xr = nr; xi = ni;
    }
  }
}

__device__ __forceinline__ void ph_ssmy(const bf16_t* ug, const bf16_t* Xc, const bf16_t* YT, const float* dskip, bf16_t* gy, bf16_t* sm) {
  LANE_IDS
  for (int t = blockIdx.x; t < 64 * 16 * 2; t += gridDim.x) {
    const int g = t >> 5, mt = (t >> 1) & 15, nt = t & 1, m0 = mt * 128, n0 = nt * 128;
    const bf16_t* ugg = ug + (size_t)g * 2048 * 256;
    ALSsmY al{ugg, Xc + (size_t)g * 128};
    f32x4 acc[4][4]; zero_acc(acc);
    kloop<ALSsmY, false>(acc, al, YT + (size_t)g * 256 * 384, 384, m0, n0, 384, sm);
    const f32x4 dv = *(const f32x4*)(dskip + g * 16 + lq * 4);
#pragma unroll
    for (int m = 0; m < 4; ++m) {
      const int row = m0 + ROWL(m);
#pragma unroll
      for (int n = 0; n < 4; ++n) {
        const int tt = (n0 + wc * 64 + n * 16) >> 4;
        const u32x2 uu = *(const u32x2*)(ugg + (size_t)row * 256 + tt * 16 + lq * 4);
        f32x4 y = acc[m][n];
        y[0] += dv[0] * bflo(uu.x); y[1] += dv[1] * bfhi(uu.x); y[2] += dv[2] * bflo(uu.y); y[3] += dv[3] * bfhi(uu.y);
        u32x2 o; o.x = pack2(gelu_t(y[0]), gelu_t(y[1])); o.y = pack2(gelu_t(y[2]), gelu_t(y[3]));
        *(u32x2*)(gy + (size_t)(row * 16 + tt) * 1024 + g * 16 + lq * 4) = o;
      }
    }
  }
}

__device__ __forceinline__ void ph_wglu(const bf16_t* gy, const bf16_t* WgluT, const float* xsrc, float* xdst, bf16_t* xb, bf16_t* sm) {
  LANE_IDS
  ALBf al{gy, 1024};
  for (int t = blockIdx.x; t < 256 * 16; t += gridDim.x) {
    const int mt = t >> 4, nt = t & 15, m0 = mt * 128, n0 = nt * 128;
    f32x4 acc[4][4]; zero_acc(acc);
    kloop<ALBf, false>(acc, al, WgluT, 1024, m0, n0, 1024, sm);
#pragma unroll
    for (int m = 0; m < 4; ++m) {
      const size_t rowoff = (size_t)(m0 + ROWL(m)) * 1024;
#pragma unroll
      for (int q = 0; q < 2; ++q) {
        const int oc = ((n0 + wc * 64) >> 1) + q * 16 + lq * 4;
        const f32x4 val = acc[m][2 * q], gate = acc[m][2 * q + 1];
        f32x4 xo = *(const f32x4*)(xsrc + rowoff + oc);
#pragma unroll
        for (int r = 0; r < 4; ++r) xo[r] += val[r] * sigm(gate[r]);
        *(f32x4*)(xdst + rowoff + oc) = xo;
        u32x2 o; o.x = pack2(xo[0], xo[1]); o.y = pack2(xo[2], xo[3]);
        *(u32x2*)(xb + rowoff + oc) = o;
      }
    }
  }
}

__device__ __forceinline__ void ph_resid(const bf16_t* A, int K, const bf16_t* Bt, float* x, bf16_t* xb, bf16_t* sm) {
  LANE_IDS
  ALBf al{A, K};
  for (int t = blockIdx.x; t < 256 * 8; t += gridDim.x) {
    const int mt = t >> 3, nt = t & 7, m0 = mt * 128, n0 = nt * 128;
    f32x4 acc[4][4]; zero_acc(acc);
    kloop<ALBf, false>(acc, al, Bt, K, m0, n0, K, sm);
#pragma unroll
    for (int m = 0; m < 4; ++m) {
      const size_t rowoff = (size_t)(m0 + ROWL(m)) * 1024;
#pragma unroll
      for (int n = 0; n < 4; ++n) {
        const int oc = n0 + COLL(n);
        f32x4 xo = *(const f32x4*)(x + rowoff + oc);
        xo += acc[m][n];
        *(f32x4*)(x + rowoff + oc) = xo;
        u32x2 o; o.x = pack2(xo[0], xo[1]); o.y = pack2(xo[2], xo[3]);
        *(u32x2*)(xb + rowoff + oc) = o;
      }
    }
  }
}

__device__ __forceinline__ void ph_halo(const bf16_t* xb, const bf16_t* WupT, float* halo, bf16_t* sm) {
  LANE_IDS
  ALHalo al{xb};
  for (int t = blockIdx.x; t < 4 * 44; t += gridDim.x) {
    const int mt = t / 44, nt = t % 44, m0 = mt * 128, n0 = nt * 128;
    f32x4 acc[4][4]; zero_acc(acc);
    kloop<ALHalo, true>(acc, al, WupT, 1024, m0, n0, 1024, sm);
    const float* rs = (const float*)sm;
#pragma unroll
    for (int m = 0; m < 4; ++m) {
      const float rstd = rsqrtf(rs[ROWL(m)] * (1.f / 1024.f) + EPSF);
#pragma unroll
      for (int n = 0; n < 4; ++n) *(f32x4*)(halo + (size_t)(m0 + ROWL(m)) * 5632 + n0 + COLL(n)) = acc[m][n] * rstd;
    }
  }
}

__device__ __forceinline__ void ph_up(const bf16_t* xb, const bf16_t* WupT, const float* halo, const float* convw, const float* convb, bf16_t* act, bf16_t* sm) {
  LANE_IDS
  ALBf al{xb, 1024};
  bf16_t* st = sm + 512;
  for (int t = blockIdx.x; t < 256 * 44; t += gridDim.x) {
    const int mt = t / 44, nt = t % 44, m0 = mt * 128, n0 = nt * 128;
    f32x4 acc[4][4]; zero_acc(acc);
    kloop<ALBf, true>(acc, al, WupT, 1024, m0, n0, 1024, sm);
    const float* rs = (const float*)sm;
#pragma unroll
    for (int m = 0; m < 4; ++m) {
      const float rstd = rsqrtf(rs[ROWL(m)] * (1.f / 1024.f) + EPSF);
#pragma unroll
      for (int n = 0; n < 4; ++n) {
        const f32x4 v = acc[m][n] * rstd;
        u32x2 o; o.x = pack2(v[0], v[1]); o.y = pack2(v[2], v[3]);
        *(u32x2*)(st + (2 + ROWL(m)) * 128 + COLL(n)) = o;
      }
    }
    {
      const int j = tid >> 7, col = tid & 127;
      float hv = 0.f;
      if ((m0 & 2047) != 0) hv = halo[(size_t)(2 * mt + j) * 5632 + n0 + col];
      st[j * 128 + col] = f2bf(hv);
    }
    __syncthreads();
    {
      const int cp = tid & 31, rg = tid >> 5;
      const int hc = nt * 64 + 2 * cp;
      float wg[3][2], wv[3][2], bg[2], bv[2];
#pragma unroll
      for (int e = 0; e < 2; ++e) {
#pragma unroll
        for (int j = 0; j < 3; ++j) { wg[j][e] = convw[j * 5632 + hc + e]; wv[j][e] = convw[j * 5632 + 2816 + hc + e]; }
        bg[e] = convb[hc + e]; bv[e] = convb[2816 + hc + e];
      }
      const int r0 = rg * 16;
      uint32_t g2 = *(const uint32_t*)(st + (r0) * 128 + 2 * cp), v2 = *(const uint32_t*)(st + (r0) * 128 + 64 + 2 * cp);
      uint32_t g1 = *(const uint32_t*)(st + (r0 + 1) * 128 + 2 * cp), v1 = *(const uint32_t*)(st + (r0 + 1) * 128 + 64 + 2 * cp);
#pragma unroll 4
      for (int r = 0; r < 16; ++r) {
        const uint32_t g0 = *(const uint32_t*)(st + (r0 + r + 2) * 128 + 2 * cp), v0 = *(const uint32_t*)(st + (r0 + r + 2) * 128 + 64 + 2 * cp);
        const float cg0 = bg[0] + wg[0][0] * bflo(g2) + wg[1][0] * bflo(g1) + wg[2][0] * bflo(g0);
        const float cg1 = bg[1] + wg[0][1] * bfhi(g2) + wg[1][1] * bfhi(g1) + wg[2][1] * bfhi(g0);
        const float cv0 = bv[0] + wv[0][0] * bflo(v2) + wv[1][0] * bflo(v1) + wv[2][0] * bflo(v0);
        const float cv1 = bv[1] + wv[0][1] * bfhi(v2) + wv[1][1] * bfhi(v1) + wv[2][1] * bfhi(v0);
        *(uint32_t*)(act + (size_t)(m0 + r0 + r) * 2816 + hc) = pack2(gelu_t(cg0) * cv0, gelu_t(cg1) * cv1);
        g2 = g1; g1 = g0; v2 = v1; v1 = v0;
      }
    }
  }
}

__device__ __forceinline__ void ph_ple(const bf16_t* xb, const bf16_t* WgtT, const float* pin, const bf16_t* WpjT, float* x, bf16_t* sm) {
  LANE_IDS
  ALBf alx{xb, 1024};
  ALF32 alp{pin, 256};
  for (int t = blockIdx.x; t < 256 * 8; t += gridDim.x) {
    const int mt = t >> 3, nt = t & 7, m0 = mt * 128, n0 = nt * 128;
    u32x2 pp[4][4];
    {
      f32x4 accp[4][4]; zero_acc(accp);
      kloop<ALF32, false>(accp, alp, WpjT, 256, m0, n0, 256, sm);
#pragma unroll
      for (int m = 0; m < 4; ++m)
#pragma unroll
        for (int n = 0; n < 4; ++n) { pp[m][n].x = pack2(accp[m][n][0], accp[m][n][1]); pp[m][n].y = pack2(accp[m][n][2], accp[m][n][3]); }
    }
    f32x4 accg[4][4]; zero_acc(accg);
    kloop<ALBf, true>(accg, alx, WgtT, 1024, m0, n0, 1024, sm);
    const float* rs = (const float*)sm;
#pragma unroll
    for (int m = 0; m < 4; ++m) {
      const float rstd = rsqrtf(rs[ROWL(m)] * (1.f / 1024.f) + EPSF);
      const size_t rowoff = (size_t)(m0 + ROWL(m)) * 1024;
#pragma unroll
      for (int n = 0; n < 4; ++n) {
        const int oc = n0 + COLL(n);
        f32x4 xo = *(const f32x4*)(x + rowoff + oc);
        xo[0] += sigm(accg[m][n][0] * rstd) * bflo(pp[m][n].x);
        xo[1] += sigm(accg[m][n][1] * rstd) * bfhi(pp[m][n].x);
        xo[2] += sigm(accg[m][n][2] * rstd) * bflo(pp[m][n].y);
        xo[3] += sigm(accg[m][n][3] * rstd) * bfhi(pp[m][n].y);
        *(f32x4*)(x + rowoff + oc) = xo;
      }
    }
  }
}

__device__ __forceinline__ void ph_kvq(const float* x, const bf16_t* Wt, int NT, int coloff, const float* knorm, const float* qnorm,
                       bf16_t* Kb, bf16_t* Vt, bf16_t* Qb, bf16_t* sm) {
  LANE_IDS
  ALF32 al{x, 1024};
  const float qscale = 0.125f * 1.4426950408889634f;
  for (int t = blockIdx.x; t < 256 * NT; t += gridDim.x) {
    const int mt = t / NT, nt = t % NT, m0 = mt * 128, n0 = nt * 128;
    f32x4 acc[4][4]; zero_acc(acc);
    kloop<ALF32, true>(acc, al, Wt, 1024, m0, n0, 1024, sm);
    const float* rs = (const float*)sm;
    const int cw = coloff + n0 + wc * 64;
#pragma unroll
    for (int m = 0; m < 4; ++m) {
      const float rstd = rsqrtf(rs[ROWL(m)] * (1.f / 1024.f) + EPSF);
      const int tok = m0 + ROWL(m);
      f32x4 v[4];
      float ss = 0.f;
#pragma unroll
      for (int n = 0; n < 4; ++n) { v[n] = acc[m][n] * rstd; ss += v[n][0] * v[n][0] + v[n][1] * v[n][1] + v[n][2] * v[n][2] + v[n][3] * v[n][3]; }
      if (cw >= 1024 && cw < 2048) {
        const int b = tok >> 11, tt = tok & 2047;
#pragma unroll
        for (int n = 0; n < 4; ++n)
#pragma unroll
          for (int r = 0; r < 4; ++r) {
            const int j = cw - 1024 + n * 16 + lq * 4 + r;
            Vt[((size_t)(b * 1024 + j)) * 2048 + tt] = f2bf(v[n][r]);
          }
      } else {
        ss += __shfl_xor(ss, 16); ss += __shfl_xor(ss, 32);
        const bool isq = cw >= 2048;
        const float hn = rsqrtf(ss * (1.f / 64.f) + EPSF) * (isq ? qscale : 1.f);
        const float* gn = isq ? qnorm : knorm;
        bf16_t* dst = isq ? (Qb + (size_t)tok * 1024 + (cw - 2048)) : (Kb + (size_t)tok * 1024 + cw);
#pragma unroll
        for (int n = 0; n < 4; ++n) {
          const f32x4 gv = *(const f32x4*)(gn + n * 16 + lq * 4);
          u32x2 o; o.x = pack2(v[n][0] * hn * gv[0], v[n][1] * hn * gv[1]); o.y = pack2(v[n][2] * hn * gv[2], v[n][3] * hn * gv[3]);
          *(u32x2*)(dst + n * 16 + lq * 4) = o;
        }
      }
    }
  }
}

__device__ __forceinline__ void ph_attn(bf16_t* QOp, const bf16_t* Kbp, const bf16_t* Vtp, const float* tabgp, const float* lq1, const float* lk1,
                        const float* lq2, const float* lk2, const float* subln, float lam_init, char* smc) {
  LANE_IDS
  char* Qs = smc;
  float* tab = (float*)(smc + 17408);
  char* stg = smc + 18432;
  float s1 = 0.f, s2 = 0.f;
  for (int d = 0; d < 64; ++d) { s1 += lq1[d] * lk1[d]; s2 += lq2[d] * lk2[d]; }
  const float lam = expf(s1) - expf(s2) + lam_init;
  const float osc = 1.f - lam_init;
  for (int u = blockIdx.x; u < 4096; u += gridDim.x) {
    const int qb = 31 - (u >> 7), bh = u & 127, b = bh >> 3, h = bh & 7;
    const int q0 = qb * 64, tb = b * 2048;
    const int qpos = q0 + wid * 16 + lr;
    const bf16_t* kbase = Kbp + (size_t)tb * 1024 + h * 128;
    const bf16_t* vbase = Vtp + (size_t)(b * 8 + h) * 128 * 2048;
    const int nkt = 2 * (qb + 1);
    u32x4 kreg[2], vreg[2];
    if (tid < 129) tab[tid] = tabgp[h * 132 + tid];
#pragma unroll
    for (int i = 0; i < 4; ++i) {
      const int v = lane + 64 * i, qr = v >> 4, part = v & 15;
      *(u32x4*)(Qs + (wid * 16 + qr) * 272 + part * 16) = *(const u32x4*)(QOp + (size_t)(tb + q0 + wid * 16 + qr) * 1024 + h * 128 + part * 8);
    }
#pragma unroll
    for (int i = 0; i < 2; ++i) {
      const int v = tid + 256 * i;
      kreg[i] = *(const u32x4*)(kbase + (size_t)(v >> 4) * 1024 + (v & 15) * 8);
      vreg[i] = *(const u32x4*)(vbase + (size_t)(v >> 2) * 2048 + (v & 3) * 8);
    }
#pragma unroll
    for (int i = 0; i < 2; ++i) {
      const int v = tid + 256 * i;
      *(u32x4*)(stg + (v >> 4) * 272 + (v & 15) * 16) = kreg[i];
      char* vp = stg + 8704 + (v >> 2) * 72 + (v & 3) * 16;
      *(u32x2*)(vp) = (u32x2){vreg[i].x, vreg[i].y};
      *(u32x2*)(vp + 8) = (u32x2){vreg[i].z, vreg[i].w};
    }
    __syncthreads();
    f32x4 oacc[2][8];
#pragma unroll
    for (int c = 0; c < 2; ++c)
#pragma unroll
      for (int e = 0; e < 8; ++e) oacc[c][e] = (f32x4){0.f, 0.f, 0.f, 0.f};
    float mrun[2] = {-1e30f, -1e30f}, lrun[2] = {0.f, 0.f};
    for (int kt = 0; kt < nkt; ++kt) {
      const char* Ks = stg + (kt & 1) * 17920;
      const char* Vs = Ks + 8704;
      if (kt + 1 < nkt) {
#pragma unroll
        for (int i = 0; i < 2; ++i) {
          const int v = tid + 256 * i;
          kreg[i] = *(const u32x4*)(kbase + (size_t)((kt + 1) * 32 + (v >> 4)) * 1024 + (v & 15) * 8);
          vreg[i] = *(const u32x4*)(vbase + (size_t)(v >> 2) * 2048 + (kt + 1) * 32 + (v & 3) * 8);
        }
      }
      const bool far = (q0 + wid * 16 - (kt * 32 + 31)) >= 128;
      const float bfar = tab[128];
      bf16x8 pk[2];
#pragma unroll
      for (int c = 0; c < 2; ++c) {
        f32x4 sacc[2];
#pragma unroll
        for (int nf = 0; nf < 2; ++nf) {
          f32x4 a = (f32x4){0.f, 0.f, 0.f, 0.f};
#pragma unroll
          for (int ks = 0; ks < 2; ++ks) {
            const bf16x8 kf = *(const bf16x8*)(Ks + (nf * 16 + lr) * 272 + (c * 64 + ks * 32 + lq * 8) * 2);
            const bf16x8 qfr = *(const bf16x8*)(Qs + (wid * 16 + lr) * 272 + (c * 64 + ks * 32 + lq * 8) * 2);
            a = __builtin_amdgcn_mfma_f32_16x16x32_bf16(kf, qfr, a, 0, 0, 0);
          }
          sacc[nf] = a;
        }
        float mx = -1e30f;
#pragma unroll
        for (int nf = 0; nf < 2; ++nf)
#pragma unroll
          for (int r = 0; r < 4; ++r) {
            const int dist = qpos - (kt * 32 + nf * 16 + lq * 4 + r);
            float bias = bfar;
            if (!far) { int idx = dist < 0 ? 0 : (dist > 128 ? 128 : dist); bias = tab[idx]; }
            const float sv = dist < 0 ? -1e30f : sacc[nf][r] + bias;
            sacc[nf][r] = sv;
            mx = fmaxf(mx, sv);
          }
        mx = fmaxf(mx, __shfl_xor(mx, 16)); mx = fmaxf(mx, __shfl_xor(mx, 32));
        const float mnew = fmaxf(mrun[c], mx);
        const float alpha = exp2f(mrun[c] - mnew);
        mrun[c] = mnew;
        float ps = 0.f;
#pragma unroll
        for (int nf = 0; nf < 2; ++nf)
#pragma unroll
          for (int r = 0; r < 4; ++r) { const float p = exp2f(sacc[nf][r] - mnew); sacc[nf][r] = p; ps += p; }
        lrun[c] = lrun[c] * alpha + ps;
#pragma unroll
        for (int e = 0; e < 8; ++e) oacc[c][e] *= alpha;
        union { uint32_t u[4]; bf16x8 v; } cvt;
        cvt.u[0] = pack2(sacc[0][0], sacc[0][1]); cvt.u[1] = pack2(sacc[0][2], sacc[0][3]);
        cvt.u[2] = pack2(sacc[1][0], sacc[1][1]); cvt.u[3] = pack2(sacc[1][2], sacc[1][3]);
        pk[c] = cvt.v;
      }
#pragma unroll
      for (int ef = 0; ef < 8; ++ef) {
        const char* vp = Vs + (ef * 16 + lr) * 72 + (lq * 4) * 2;
        union { u32x2 h[2]; bf16x8 v; } vf;
        vf.h[0] = *(const u32x2*)(vp); vf.h[1] = *(const u32x2*)(vp + 32);
        oacc[0][ef] = __builtin_amdgcn_mfma_f32_16x16x32_bf16(vf.v, pk[0], oacc[0][ef], 0, 0, 0);
        oacc[1][ef] = __builtin_amdgcn_mfma_f32_16x16x32_bf16(vf.v, pk[1], oacc[1][ef], 0, 0, 0);
      }
      if (kt + 1 < nkt) {
        char* Kn = stg + ((kt + 1) & 1) * 17920;
#pragma unroll
        for (int i = 0; i < 2; ++i) {
          const int v = tid + 256 * i;
          *(u32x4*)(Kn + (v >> 4) * 272 + (v & 15) * 16) = kreg[i];
          char* vp = Kn + 8704 + (v >> 2) * 72 + (v & 3) * 16;
          *(u32x2*)(vp) = (u32x2){vreg[i].x, vreg[i].y};
          *(u32x2*)(vp + 8) = (u32x2){vreg[i].z, vreg[i].w};
        }
      }
      __syncthreads();
    }
    float l0 = lrun[0], l1 = lrun[1];
    l0 += __shfl_xor(l0, 16); l0 += __shfl_xor(l0, 32);
    l1 += __shfl_xor(l1, 16); l1 += __shfl_xor(l1, 32);
    const float i0 = 1.f / l0, i1 = lam / l1;
    float ss = 0.f;
#pragma unroll
    for (int e = 0; e < 8; ++e) {
      oacc[0][e] = oacc[0][e] * i0 - oacc[1][e] * i1;
      ss += oacc[0][e][0] * oacc[0][e][0] + oacc[0][e][1] * oacc[0][e][1] + oacc[0][e][2] * oacc[0][e][2] + oacc[0][e][3] * oacc[0][e][3];
    }
    ss += __shfl_xor(ss, 16); ss += __shfl_xor(ss, 32);
    const float rn = rsqrtf(ss * (1.f / 128.f) + EPSF) * osc;
#pragma unroll
    for (int e = 0; e < 8; ++e) {
      const f32x4 gv = *(const f32x4*)(subln + e * 16 + lq * 4);
      const f32x4 o = oacc[0][e] * rn * gv;
      u32x2 w; w.x = pack2(o[0], o[1]); w.y = pack2(o[2], o[3]);
      *(u32x2*)(QOp + (size_t)(tb + qpos) * 1024 + h * 128 + e * 16 + lq * 4) = w;
    }
  }
}

#define PHASE_PTRS int z = 0; asm volatile("" : "+s"(z)); char* ws = P.ws + z; const float* const* in = P.in + z; float* x = P.out + z; (void)ws; (void)in; (void)x;
#define WinT ((bf16_t*)(ws + OFF_WIN))
#define WgluT ((bf16_t*)(ws + OFF_WGLU))
#define PT ((bf16_t*)(ws + OFF_PT))
#define YT ((bf16_t*)(ws + OFF_YT))
#define WkvqT ((bf16_t*)(ws + OFF_WKVQ))
#define WoT ((bf16_t*)(ws + OFF_WO))
#define WupT ((bf16_t*)(ws + OFF_WUP))
#define WdnT ((bf16_t*)(ws + OFF_WDN))
#define WgtT ((bf16_t*)(ws + OFF_WGT))
#define WpjT ((bf16_t*)(ws + OFF_WPJ))
#define a16 ((float*)(ws + OFF_SMALL))
#define tabg ((float*)(ws + OFF_SMALL + 65536))
#define xb ((bf16_t*)(ws + OFF_XB))
#define ug ((bf16_t*)(ws + OFF_UG))
#define S_ ((float*)(ws + OFF_S))
#define Xc ((bf16_t*)(ws + OFF_XC))
#define gy ((bf16_t*)(ws + OFF_GY))
#define Kb ((bf16_t*)(ws + OFF_K))
#define Vt ((bf16_t*)(ws + OFF_VT))
#define QO ((bf16_t*)(ws + OFF_QO))
#define act ((bf16_t*)(ws + OFF_ACT))
#define halo ((float*)(ws + OFF_HALO))
__global__ void __launch_bounds__(256, 2) yoco_mega(Params P) {
  __shared__ __attribute__((aligned(16))) char smraw[65536];
  bf16_t* sm = (bf16_t*)smraw;
  float* smf = (float*)smraw;
  for (int ph = P.ph_lo; ph < P.ph_hi; ++ph) {
    const int L = ph / 10, s = ph % 10;
    const bool isA = L < 2;
    const int j = L - 2;
    if (s == 0) {
      PHASE_PTRS
      if (isA) prep_ssm(in[4] + L * 64, in[5] + L * 4096, in[6] + L * 4096, in[7] + (size_t)L * 65536, in[8] + (size_t)L * 65536,
                        in[9] + (size_t)L * 65536, in[10] + (size_t)L * 65536, PT, YT, a16, smf);
      else if (j == 0) prep_bias(in[25], tabg);
#pragma unroll 1
      for (int mi = 0; mi < 7; ++mi) {
        const float* src = nullptr; const float* gain = nullptr; bf16_t* dst = nullptr; int K = 1024, N = 1024, Nsub = 1024, mode = 0;
        if (mi == 0) { src = in[27] + (size_t)L * 1024 * 5632; N = 5632; Nsub = 5632; dst = WupT; gain = in[26] + L * 1024; mode = 2; }
        else if (mi == 1) { src = in[30] + (size_t)L * 2816 * 1024; K = 2816; dst = WdnT; }
        else if (mi == 2) { src = in[32] + (size_t)L * 1024 * 1024; dst = WgtT; gain = in[31] + L * 1024; }
        else if (mi == 3) { src = in[33] + (size_t)L * 256 * 1024; K = 256; dst = WpjT; }
        else if (isA) {
          if (mi == 4) { src = in[3] + (size_t)L * 1024 * 1024; dst = WinT; gain = in[2] + L * 1024; }
          else if (mi == 5) { src = in[12] + (size_t)L * 1024 * 2048; N = 2048; Nsub = 2048; dst = WgluT; mode = 1; }
          else continue;
        } else {
          if (mi == 4) { src = in[24] + (size_t)j * 1024 * 1024; dst = WoT; }
          else if (mi == 5) { src = in[17] + (size_t)j * 1024 * 1024; dst = WkvqT + (j == 0 ? (size_t)2048 * 1024 : 0); gain = in[16] + j * 1024; }
          else if (j == 0) { src = in[14]; N = 2048; Nsub = 2048; dst = WkvqT; gain = in[13]; }
          else continue;
        }
        prep_mat(src, K, N, Nsub, dst, gain, mode, smf);
      }
    } else if (s == 1) {
      PHASE_PTRS
      if (isA) ph_win(L == 0 ? in[0] : x, WinT, ug, sm);
      else ph_kvq(x, WkvqT, j == 0 ? 24 : 8, j == 0 ? 0 : 2048, in[15], in[18] + j * 64, Kb, Vt, QO, sm);
    } else if (s == 2) {
      PHASE_PTRS
      if (isA) ph_sstate(ug, PT, S_, sm);
      else ph_attn(QO, Kb, Vt, tabg, in[19] + j * 64, in[20] + j * 64, in[21] + j * 64, in[22] + j * 64, in[23] + j * 128,
                   0.8f - 0.6f * expf(-0.3f * (float)L), smraw);
    } else if (s == 3) {
      PHASE_PTRS
      if (isA) ph_scan(S_, a16, Xc);
    } else if (s == 4) {
      PHASE_PTRS
      if (isA) ph_ssmy(ug, Xc, YT, in[11] + L * 1024, gy, sm);
    } else if (s == 5) {
      PHASE_PTRS
      if (isA) ph_wglu(gy, WgluT, L == 0 ? in[0] : x, x, xb, sm);
    } else if (s == 6) {
      PHASE_PTRS
      ph_halo(xb, WupT, halo, sm);
    } else if (s == 7) {
      PHASE_PTRS
      ph_up(xb, WupT, halo, in[28] + (size_t)L * 3 * 5632, in[29] + (size_t)L * 5632, act, sm);
    } else if (s == 8) {
      PHASE_PTRS
      ;
    } else {
      PHASE_PTRS
      ph_ple(xb, WgtT, in[1] + (size_t)L * 32768 * 256, WpjT, x, sm);
    }
    if ((s == 3 && !isA) || s == 8) {
      PHASE_PTRS
      const bool dn = s == 8;
      ph_resid(dn ? act : QO, dn ? 2816 : 1024, dn ? WdnT : WoT, x, xb, sm);
    }
    if (P.coop && ph + 1 < P.ph_hi && !(!isA && (s == 4 || s == 5))) cg::this_grid().sync();
  }
}

extern "C" void kernel_launch(void* const* d_in, const int* in_sizes, int n_in, void* d_out, int out_size, void* d_ws, size_t ws_size,
                              hipStream_t stream) {
  static int grid_blocks = 0;
  if (!grid_blocks) {
    int dev = 0, cus = 0, per_cu = 0;
    hipGetDevice(&dev);
    hipDeviceGetAttribute(&cus, hipDeviceAttributeMultiprocessorCount, dev);
    hipOccupancyMaxActiveBlocksPerMultiprocessor(&per_cu, yoco_mega, 256, 0);
    if (per_cu < 1) per_cu = 1;
    if (per_cu > 2) per_cu = 2;
    grid_blocks = cus * per_cu;
    if (ws_size < WS_NEED) fprintf(stderr, "workspace too small: %zu < %llu\n", ws_size, (unsigned long long)WS_NEED);
  }
  Params P;
  memset(&P, 0, sizeof(P));
  for (int i = 0; i < 34; ++i) P.in[i] = (const float*)d_in[i];
  P.out = (float*)d_out;
  P.ws = (char*)d_ws;
#if MK_SINGLE
  P.ph_lo = 0; P.ph_hi = 40; P.coop = 1;
  void* args[] = {&P};
  hipError_t e = hipLaunchCooperativeKernel((void*)yoco_mega, dim3(grid_blocks), dim3(256), args, 0, stream);
  if (e != hipSuccess) fprintf(stderr, "cooperative launch failed: %s (grid %d)\n", hipGetErrorString(e), grid_blocks);
#else
  for (int ph = 0; ph < 40; ++ph) {
    const int L = ph / 10, s = ph % 10;
    if (L >= 2 && (s == 4 || s == 5)) continue;
    P.ph_lo = ph; P.ph_hi = ph + 1; P.coop = 0;
    hipLaunchKernelGGL(yoco_mega, dim3(grid_blocks), dim3(256), 0, stream, P);
  }
#endif
}
```

```cpp
#include <hip/hip_runtime.h>
#include <hip/hip_cooperative_groups.h>
#include <stdint.h>
#include <stdio.h>
#include <string.h>
namespace cg = cooperative_groups;

typedef unsigned short bf16_t;
typedef short bf16x8 __attribute__((ext_vector_type(8)));
typedef float f32x4 __attribute__((ext_vector_type(4)));
typedef unsigned int u32x4 __attribute__((ext_vector_type(4)));
typedef unsigned int u32x2 __attribute__((ext_vector_type(2)));
typedef unsigned long long rss_t;
#define RSS_SCALE 16777216.f
#define LAS __attribute__((address_space(3)))

#ifndef REPMASK
#define REPMASK 0
#endif
#ifndef MK_SINGLE
#define MK_SINGLE 1
#endif

#define NTHR 512
#define LDS_BYTES 139264
#define EPSF 1e-6f
#define MIB (1ull << 20)
#define OFF_WIN  (0 * MIB)
#define OFF_WGLU (2 * MIB)
#define OFF_PT   (6 * MIB)
#define OFF_YT   (10 * MIB)
#define OFF_WKVQ (0 * MIB)
#define OFF_WO   (6 * MIB)
#define OFF_WUP  (22 * MIB)
#define OFF_WDN  (33 * MIB)
#define OFF_WGT  (39 * MIB)
#define OFF_WPJ  (41 * MIB)
#define OFF_SMALL (42 * MIB)
#define OFF_PBF  (46 * MIB)
#define OFF_XB0  (62 * MIB)
#define OFF_XB1  (126 * MIB)
#define OFF_UG   (190 * MIB)
#define OFF_S    (254 * MIB)
#define OFF_XC   (318 * MIB)
#define OFF_GY   (350 * MIB)
#define OFF_K    (190 * MIB)
#define OFF_VT   (254 * MIB)
#define OFF_QO   (318 * MIB)
#define OFF_ACT  (318 * MIB)
#define OFF_HALO (494 * MIB)
#define WS_NEED  (505 * MIB)

struct Params {
  const float* in[34];
  float* out;
  char* ws;
  int ph_lo, ph_hi, coop, pad;
};

__device__ __forceinline__ bf16_t f2bf(float f) {
  uint32_t u = __float_as_uint(f);
  u += 0x7fffu + ((u >> 16) & 1u);
  return (bf16_t)(u >> 16);
}
typedef __bf16 bf16v2 __attribute__((ext_vector_type(2)));
__device__ __forceinline__ uint32_t pack2(float a, float b) { bf16v2 v; v[0] = (__bf16)a; v[1] = (__bf16)b; return __builtin_bit_cast(uint32_t, v); }
__device__ __forceinline__ float bflo(uint32_t u) { return __uint_as_float(u << 16); }
__device__ __forceinline__ float bfhi(uint32_t u) { return __uint_as_float(u & 0xffff0000u); }
__device__ __forceinline__ float gelu_t(float x) {
  const float t = x * x;
  const float e = __builtin_amdgcn_exp2f(x * (-2.302208198f - 0.1029432397f * t));
  return x * __builtin_amdgcn_rcpf(1.f + e);
}
__device__ __forceinline__ float sigm(float x) { return __builtin_amdgcn_rcpf(1.f + __builtin_amdgcn_exp2f(-1.4426950408889634f * x)); }
__device__ __forceinline__ float sq4(f32x4 v) { return v[0] * v[0] + v[1] * v[1] + v[2] * v[2] + v[3] * v[3]; }

struct RowPlain {
  const bf16_t* A; int lda;
  __device__ __forceinline__ const char* base(int kt) const { return (const char*)(A + kt * 64); }
  __device__ __forceinline__ unsigned off(int row, int kt) const { return (unsigned)row * (unsigned)(lda * 2); }
};
struct RowHalo {
  const bf16_t* A; int ko;
  __device__ __forceinline__ const char* base(int kt) const { return (const char*)(A + (kt + ko) * 64); }
  __device__ __forceinline__ unsigned off(int row, int kt) const {
    int tok = 256 * (row >> 1) - 2 + (row & 1); tok = tok < 0 ? 0 : tok;
    return (unsigned)tok * 2048u;
  }
};
struct RowSsmY {
  const bf16_t* ugg; const bf16_t* xcg;
  __device__ __forceinline__ const char* base(int kt) const { return kt < 4 ? (const char*)(ugg + kt * 64) : (const char*)(xcg + (kt - 4) * 64); }
  __device__ __forceinline__ unsigned off(int row, int kt) const { return ((unsigned)row * 512u) << (kt < 4 ? 0 : 5); }
};

__device__ __forceinline__ const char* uni_ptr(const char* p) {
  const unsigned long long u = (unsigned long long)p;
  const unsigned lo = __builtin_amdgcn_readfirstlane((unsigned)u), hi = __builtin_amdgcn_readfirstlane((unsigned)(u >> 32));
  return (const char*)(((unsigned long long)hi << 32) | lo);
}
__device__ __forceinline__ int lds_byte(int r, int c) {
  const int st = (r >> 4) * 2 + (c >> 5), ob = (r & 15) * 64 + (c & 31) * 2;
  return st * 1024 + (ob ^ (((ob >> 9) & 1) << 5));
}
__device__ __forceinline__ void stage_rc(int b, int& R, int& C) {
  const int st = b >> 10, sb = b & 1023, swz = sb ^ (((sb >> 9) & 1) << 5);
  R = (st >> 1) * 16 + swz / 64;
  C = (st & 1) * 32 + (swz % 64) / 2;
}

template <class AR>
__device__ __forceinline__ void kloop(f32x4 (&acc)[8][4], const AR& ar, const bf16_t* __restrict__ Bt, int ldb, int m0, int n0, int nt, char* smem) {
  int tid_ = threadIdx.x; asm volatile("" : "+v"(tid_));
  const int tid = tid_, wid = tid >> 6, lane = tid & 63, wr = wid >> 2, wc = wid & 3, fr = lane & 15, fq = lane >> 4;
  int sR, sC; stage_rc(wid * 1024 + lane * 16, sR, sC);
  const unsigned sC2 = (unsigned)sC * 2u;
  const unsigned bo0 = ((unsigned)(n0 + sR) * (unsigned)ldb + (unsigned)sC) * 2u;
  const size_t bstep = (size_t)ldb * 128u;
  const int ar0 = m0 + sR;
  const unsigned ldsw = __builtin_amdgcn_readfirstlane((unsigned)(size_t)smem + (unsigned)wid * 1024u);
  __syncthreads();
#define GLDS16(ldsaddr, voff, sbase) asm volatile("s_mov_b32 m0, %0\n\tglobal_load_lds_dwordx4 %1, %2" :: "s"(ldsaddr), "v"(voff), "s"(sbase) : "memory")
#define GSTAGE(buf, kt) do { const char* ab_ = uni_ptr(ar.base(kt)); const char* bb_ = uni_ptr((const char*)(Bt + (kt) * 64)); _Pragma("unroll") for (int i = 0; i < 4; ++i) { \
    GLDS16(ldsw + (unsigned)((buf) * 65536 + i * 8192), ar.off(ar0 + 64 * i, (kt)) + sC2, ab_); \
    GLDS16(ldsw + (unsigned)((buf) * 65536 + 32768 + i * 8192), bo0, bb_ + bstep * i); } } while (0)
  GSTAGE(0, 0);
  asm volatile("s_waitcnt vmcnt(0)" ::: "memory");
  __syncthreads();
#pragma unroll 1
  for (int t = 0; t < nt; ++t) {
    const int cur = t & 1;
    if (t + 1 < nt) GSTAGE(cur ^ 1, t + 1);
    const char* sA = smem + cur * 65536;
    const char* sB = sA + 32768;
#pragma unroll
    for (int ks = 0; ks < 2; ++ks) {
      bf16x8 Bf[4], At[8];
#pragma unroll
      for (int n = 0; n < 4; ++n) Bf[n] = *(const bf16x8*)(sB + lds_byte(wc * 64 + n * 16 + fr, ks * 32 + fq * 8));
#pragma unroll
      for (int m = 0; m < 8; ++m) At[m] = *(const bf16x8*)(sA + lds_byte(wr * 128 + m * 16 + fr, ks * 32 + fq * 8));
#pragma unroll
      for (int m = 0; m < 8; ++m)
#pragma unroll
        for (int n = 0; n < 4; ++n) acc[m][n] = __builtin_amdgcn_mfma_f32_16x16x32_bf16(Bf[n], At[m], acc[m][n], 0, 0, 0);
      __builtin_amdgcn_sched_group_barrier(0x100, 8, 0);
      __builtin_amdgcn_sched_group_barrier(0x008, 4, 0);
      __builtin_amdgcn_sched_group_barrier(0x100, 2, 0);
      __builtin_amdgcn_sched_group_barrier(0x008, 4, 0);
      __builtin_amdgcn_sched_group_barrier(0x100, 2, 0);
      __builtin_amdgcn_sched_group_barrier(0x008, 24, 0);
      __builtin_amdgcn_sched_barrier(0);
    }
    asm volatile("s_waitcnt vmcnt(0)" ::: "memory");
    __syncthreads();
  }
#undef GSTAGE
#undef GLDS16
}

__device__ __forceinline__ void tile_map(int L, int nM, int nN, int& pm, int& pn) {
  const int q = (nM * nN) >> 3;
  const int wgid = (L & 7) * q + (L >> 3);
  const int nig = 8 * nN, gid = wgid / nig, r = wgid - gid * nig;
  pm = gid * 8 + (r & 7); pn = r >> 3;
}
__device__ __forceinline__ void zero_acc(f32x4 (&acc)[8][4]) {
#pragma unroll
  for (int m = 0; m < 8; ++m)
#pragma unroll
    for (int n = 0; n < 4; ++n) acc[m][n] = (f32x4){0.f, 0.f, 0.f, 0.f};
}

__device__ __forceinline__ int srccol(int n, int mode) {
  if (mode == 1) { const int q64 = n >> 6, f = (n >> 4) & 3, i = n & 15; const int oc = 32 * q64 + 8 * (i >> 2) + 4 * (f >> 1) + (i & 3);
                   return (f & 1) ? 1024 + oc : oc; }
  if (mode == 2) { const int rho = n & 31, nn = rho >> 4, i = rho & 15; const int np = (n & ~31) + 8 * (i >> 2) + 4 * nn + (i & 3);
                   const int nt = np >> 8, j = np & 255; return j < 128 ? nt * 128 + j : 2816 + nt * 128 + (j - 128); }
  if (mode == 3) { const int rho = n & 31, nn = rho >> 4, i = rho & 15; return (n & ~31) + 8 * (i >> 2) + 4 * nn + (i & 3); }
  return n;
}
__device__ __forceinline__ void prep_mat(const float* __restrict__ src, int K, int N, int Nsub, bf16_t* __restrict__ dst, const float* __restrict__ gain, int mode, float* smf) {
  int tid_ = threadIdx.x; asm volatile("" : "+v"(tid_)); const int tid = tid_;
  const int KT = K >> 6, NT = Nsub >> 6, ntile = KT * NT;
  const int j = tid & 63, kq = tid >> 6;
  float v[8];
  int t = blockIdx.x;
  if (t < ntile) {
    const int k0 = (t % KT) * 64, n0 = (t / KT) * 64; const int sc = srccol(n0 + j, mode);
#pragma unroll
    for (int i = 0; i < 8; ++i) { const int k = i * 8 + kq; v[i] = src[(size_t)(k0 + k) * N + sc] * (gain ? gain[k0 + k] : 1.f); }
  }
  for (; t < ntile; t += gridDim.x) {
    const int k0 = (t % KT) * 64, n0 = (t / KT) * 64;
    __syncthreads();
#pragma unroll
    for (int i = 0; i < 8; ++i) smf[(i * 8 + kq) * 65 + j] = v[i];
    const int tn = t + gridDim.x;
    if (tn < ntile) {
      const int k1 = (tn % KT) * 64, n1 = (tn / KT) * 64; const int sc = srccol(n1 + j, mode);
#pragma unroll
      for (int i = 0; i < 8; ++i) { const int k = i * 8 + kq; v[i] = src[(size_t)(k1 + k) * N + sc] * (gain ? gain[k1 + k] : 1.f); }
    }
    __syncthreads();
    {
      const int row = tid >> 3, kv = tid & 7;
      float w[8];
#pragma unroll
      for (int e = 0; e < 8; ++e) w[e] = smf[(kv * 8 + e) * 65 + row];
      u32x4 o; o.x = pack2(w[0], w[1]); o.y = pack2(w[2], w[3]); o.z = pack2(w[4], w[5]); o.w = pack2(w[6], w[7]);
      *(u32x4*)(dst + (size_t)(n0 + row) * K + k0 + kv * 8) = o;
    }
  }
}

__device__ __forceinline__ void ssm_consts(const float* log_dt, const float* lam_re, const float* lam_im, float* ssmc, float* a16p, int L, int g, int p) {
  const float dt = expf(log_dt[L * 64 + g]);
  const float lr = lam_re[L * 4096 + g * 64 + p], li = lam_im[L * 4096 + g * 64 + p];
  const float mag = expf(lr * dt);
  const float abr = mag * cosf(li * dt), abi = mag * sinf(li * dt);
  const float den = lr * lr + li * li;
  const float fr = ((abr - 1.f) * lr + abi * li) / den;
  const float fi = (abi * lr - (abr - 1.f) * li) / den;
  *(f32x4*)(ssmc + (size_t)((L * 64 + g) * 64 + p) * 4) = (f32x4){abr, abi, fr, fi};
  float xr = abr, xi = abi;
#pragma unroll
  for (int q = 0; q < 4; ++q) { float nr = xr * xr - xi * xi, ni = 2.f * xr * xi; xr = nr; xi = ni; }
  a16p[(size_t)L * 8192 + (g * 64 + p) * 2] = xr; a16p[(size_t)L * 8192 + (g * 64 + p) * 2 + 1] = xi;
}

__device__ __forceinline__ void prep_ssm(const float* ssmcL, const float* b_re, const float* b_im,
                         const float* c_re, const float* c_im, bf16_t* PT, bf16_t* YT, float* smf) {
  int tid_ = threadIdx.x; asm volatile("" : "+v"(tid_)); const int tid = tid_;
  float* s_abr = smf; float* s_abi = smf + 64; float* s_fr = smf + 128; float* s_fi = smf + 192;
  float* s_pr = smf + 256; float* s_pi = smf + 320;
  for (int g = blockIdx.x; g < 64; g += gridDim.x) {
    __syncthreads();
    if (tid < 64) {
      const f32x4 cc = *(const f32x4*)(ssmcL + (size_t)(g * 64 + tid) * 4);
      s_abr[tid] = cc[0]; s_abi[tid] = cc[1]; s_fr[tid] = cc[2]; s_fi[tid] = cc[3];
      s_pr[tid] = 1.f; s_pi[tid] = 0.f;
    }
    __syncthreads();
    if (tid < 256) {
      const int co = tid >> 4, ci = tid & 15;
      bf16_t* yg = YT + (size_t)g * 256 * 384;
      float kj[16];
#pragma unroll
      for (int j = 0; j < 16; ++j) kj[j] = 0.f;
#pragma unroll 2
      for (int p = 0; p < 64; ++p) {
        const float br = b_re[(g * 64 + p) * 16 + ci], bi = b_im[(g * 64 + p) * 16 + ci];
        const float fr = s_fr[p], fi = s_fi[p], ar = s_abr[p], ai = s_abi[p];
        const float bbr = fr * br - fi * bi, bbi = fr * bi + fi * br;
        const float cr = c_re[(g * 16 + co) * 64 + p], cim = c_im[(g * 16 + co) * 64 + p];
        float zr = cr * bbr - cim * bbi, zi = cr * bbi + cim * bbr;
#pragma unroll
        for (int j = 0; j < 16; ++j) { kj[j] += zr; const float nr = zr * ar - zi * ai, ni = zr * ai + zi * ar; zr = nr; zi = ni; }
      }
#pragma unroll
      for (int j = 0; j < 16; ++j) {
        const bf16_t v = f2bf(kj[j]);
#pragma unroll 1
        for (int t = j; t < 16; ++t) yg[(t * 16 + co) * 384 + (t - j) * 16 + ci] = v;
        if (j > 0) {
#pragma unroll 1
          for (int t = 0; t + j < 16; ++t) yg[(t * 16 + co) * 384 + (t + j) * 16 + ci] = 0;
        }
      }
    }
    {
      bf16_t* yg = YT + (size_t)g * 256 * 384;
#pragma unroll 1
      for (int i = 0; i < 2; ++i) {
        const int idx = tid + 512 * i, co = idx >> 6, p = idx & 63;
        const float ar = s_abr[p], ai = s_abi[p];
        float zr = c_re[(g * 16 + co) * 64 + p], zi = c_im[(g * 16 + co) * 64 + p];
#pragma unroll 1
        for (int t = 0; t < 16; ++t) {
          const float nr = zr * ar - zi * ai, ni = zr * ai + zi * ar; zr = nr; zi = ni;
          yg[(t * 16 + co) * 384 + 256 + p] = f2bf(zr);
          yg[(t * 16 + co) * 384 + 320 + p] = f2bf(-zi);
        }
      }
    }
    {
      bf16_t* pg = PT + (size_t)g * 128 * 256;
#pragma unroll 1
      for (int i = 0; i < 2; ++i) {
        const int idx = tid + 512 * i, p = idx >> 4, c = idx & 15;
        const float ar = s_abr[p], ai = s_abi[p], fr = s_fr[p], fi = s_fi[p];
        const float br = b_re[(g * 64 + p) * 16 + c], bi = b_im[(g * 64 + p) * 16 + c];
        float zr = fr * br - fi * bi, zi = fr * bi + fi * br;
#pragma unroll 1
        for (int t = 15; t >= 0; --t) {
          pg[p * 256 + t * 16 + c] = f2bf(zr);
          pg[(64 + p) * 256 + t * 16 + c] = f2bf(zi);
          const float nr = zr * ar - zi * ai, ni = zr * ai + zi * ar; zr = nr; zi = ni;
        }
      }
    }
  }
}

__device__ __forceinline__ void prep_bias(const float* rel_bias, float* tab) {
  if (blockIdx.x == 0) {
    int tid_ = threadIdx.x; asm volatile("" : "+v"(tid_));
    for (int idx = tid_; idx < 8 * 129; idx += NTHR) {
      const int h = idx / 129, n = idx % 129;
      int bucket;
      if (n < 16) bucket = n;
      else {
        bucket = 16 + (n >= 19) + (n >= 21) + (n >= 24) + (n >= 27) + (n >= 31) + (n >= 35) + (n >= 40) + (n >= 46) + (n >= 52) + (n >= 59)
                 + (n >= 67) + (n >= 77) + (n >= 87) + (n >= 99) + (n >= 113);
      }
      tab[h * 132 + n] = rel_bias[bucket * 8 + h] * 1.4426950408889634f;
    }
    if (tid_ < 8) {
      float mx = -1e30f;
      for (int bk = 0; bk < 32; ++bk) mx = fmaxf(mx, rel_bias[bk * 8 + tid_] * 1.4426950408889634f);
      tab[tid_ * 132 + 129] = mx;
    }
  }
}

__device__ __forceinline__ void prep_x(const float* xin, bf16_t* xbuf, rss_t* rowss) {
  int tid_ = threadIdx.x; asm volatile("" : "+v"(tid_)); const int tid = tid_, wid = tid >> 6, lane = tid & 63;
  for (int i = blockIdx.x * NTHR + tid; i < 12 * 32768; i += gridDim.x * NTHR) rowss[32768 + i] = 0ull;
#pragma unroll 2
  for (int row = blockIdx.x * 8 + wid; row < 32768; row += gridDim.x * 8) {
    float ss = 0.f;
#pragma unroll
    for (int i = 0; i < 2; ++i) {
      const f32x4* p = (const f32x4*)(xin + (size_t)row * 1024 + i * 512 + lane * 8);
      const f32x4 a = p[0], b = p[1];
      u32x4 o; o.x = pack2(a[0], a[1]); o.y = pack2(a[2], a[3]); o.z = pack2(b[0], b[1]); o.w = pack2(b[2], b[3]);
      *(u32x4*)(xbuf + (size_t)row * 1024 + i * 512 + lane * 8) = o;
      ss += sq4(a) + sq4(b);
    }
#pragma unroll
    for (int o = 32; o >= 1; o >>= 1) ss += __shfl_xor(ss, o);
    if (lane == 0) rowss[row] = (rss_t)(ss * RSS_SCALE + 0.5f);
  }
}
__device__ __forceinline__ void prep_p(const float* pin, bf16_t* pbf) {
  int tid_ = threadIdx.x; asm volatile("" : "+v"(tid_));
#pragma unroll 4
  for (size_t i = (size_t)blockIdx.x * NTHR + tid_; i < (size_t)32768 * 256 / 8; i += (size_t)gridDim.x * NTHR) {
    const f32x4* p = (const f32x4*)(pin + i * 8);
    const f32x4 a = p[0], b = p[1];
    u32x4 o; o.x = pack2(a[0], a[1]); o.y = pack2(a[2], a[3]); o.z = pack2(b[0], b[1]); o.w = pack2(b[2], b[3]);
    *(u32x4*)(pbf + i * 8) = o;
  }
}

#define ROWL(m) (wr * 128 + (m) * 16 + lr)
#define COLL(n) (wc * 64 + (n) * 16 + lq * 4)
#define COLP(p) (wc * 64 + (p) * 32 + lq * 8)
#define LANE_IDS int tid_ = threadIdx.x; asm volatile("" : "+v"(tid_)); const int tid = tid_, lane = tid & 63, wid = tid >> 6, wr = wid >> 2, wc = wid & 3; (void)tid; (void)lane; (void)wr; (void)wc;
#define EPI_IDS int lq = lane >> 4, lr = lane & 15; asm volatile("" : "+v"(lq), "+v"(lr));
#define RSTD(rs, row) rsqrtf((float)(rs)[row] * (1.f / (1024.f * RSS_SCALE)) + EPSF)
#define RSS_ADD(p, v) atomicAdd((p), (rss_t)((v) * RSS_SCALE + 0.5f))

__device__ __forceinline__ void ph_win(const bf16_t* xbp, const rss_t* rs, const bf16_t* Wt, bf16_t* ugp, char* smem) {
  LANE_IDS
  RowPlain ar{xbp, 1024};
  for (int t = blockIdx.x; t < 128 * 4; t += gridDim.x) {
    int mt, nt; tile_map(t, 128, 4, mt, nt); const int m0 = mt * 256, n0 = nt * 256;
    f32x4 acc[8][4]; zero_acc(acc);
    kloop(acc, ar, Wt, 1024, m0, n0, 16, smem);
    EPI_IDS
#pragma unroll
    for (int m = 0; m < 8; ++m) {
      const int tok = m0 + ROWL(m);
      const float rstd = RSTD(rs, tok);
#pragma unroll
      for (int p = 0; p < 2; ++p) {
        const int c0 = n0 + COLP(p), g = c0 >> 4;
        const f32x4 v0 = acc[m][2 * p] * rstd, v1 = acc[m][2 * p + 1] * rstd;
        u32x4 o; o.x = pack2(v0[0], v0[1]); o.y = pack2(v0[2], v0[3]); o.z = pack2(v1[0], v1[1]); o.w = pack2(v1[2], v1[3]);
        *(u32x4*)(ugp + ((size_t)(g * 2048 + (tok >> 4)) * 256 + (tok & 15) * 16 + (c0 & 15))) = o;
      }
    }
  }
}

__device__ __forceinline__ void ph_sstate(const bf16_t* ugp, const bf16_t* PTp, float* S, char* smem) {
  LANE_IDS
  for (int t = blockIdx.x; t < 64 * 8; t += gridDim.x) {
    const int g = t >> 3, mt = t & 7, m0 = mt * 256;
    RowPlain ar{ugp + (size_t)g * 2048 * 256, 256};
    f32x4 acc[8][4]; zero_acc(acc);
    kloop(acc, ar, PTp + (size_t)g * 128 * 256, 256, m0, 0, 4, smem);
    EPI_IDS
    if (wc < 2) {
#pragma unroll
      for (int m = 0; m < 8; ++m) {
        const int row = m0 + ROWL(m);
#pragma unroll
        for (int n = 0; n < 4; ++n) *(f32x4*)(S + ((size_t)row * 64 + g) * 128 + COLL(n)) = acc[m][n];
      }
    }
  }
}

__device__ __forceinline__ void ph_scan(const float* S, const float* a16p, bf16_t* Xcp) {
  int tid_ = threadIdx.x; asm volatile("" : "+v"(tid_));
  for (int idx = blockIdx.x * NTHR + tid_; idx < 16 * 64 * 64; idx += gridDim.x * NTHR) {
    const int p = idx & 63, g = (idx >> 6) & 63, b = idx >> 12;
    const float ar = a16p[(g * 64 + p) * 2], ai = a16p[(g * 64 + p) * 2 + 1];
    float xr = 0.f, xi = 0.f;
#pragma unroll 8
    for (int c = 0; c < 128; ++c) {
      const size_t off = ((size_t)(b * 128 + c) * 64 + g) * 128;
      Xcp[off + p] = f2bf(xr); Xcp[off + 64 + p] = f2bf(xi);
      const float sr = S[off + p], si = S[off + 64 + p];
      const float nr = ar * xr - ai * xi + sr, ni = ar * xi + ai * xr + si;
      xr = nr; xi = ni;
    }
  }
}

__device__ __forceinline__ void ph_ssmy(const bf16_t* ugp, const bf16_t* Xcp, const bf16_t* YTp, const float* dskip, bf16_t* gyp, char* smem) {
  LANE_IDS
  for (int t = blockIdx.x; t < 64 * 8; t += gridDim.x) {
    const int g = t >> 3, mt = t & 7, m0 = mt * 256;
    const bf16_t* ugg = ugp + (size_t)g * 2048 * 256;
    RowSsmY ar{ugg, Xcp + (size_t)g * 128};
    f32x4 acc[8][4]; zero_acc(acc);
    kloop(acc, ar, YTp + (size_t)g * 256 * 384, 384, m0, 0, 6, smem);
    EPI_IDS
    const f32x4 dv = *(const f32x4*)(dskip + g * 16 + lq * 4);
#pragma unroll
    for (int m = 0; m < 8; ++m) {
      asm volatile("" ::: "memory");
      const int row = m0 + ROWL(m);
#pragma unroll
      for (int n = 0; n < 4; ++n) {
        const int tt = wc * 4 + n;
        const u32x2 uu = *(const u32x2*)(ugg + (size_t)row * 256 + tt * 16 + lq * 4);
        f32x4 y = acc[m][n];
        y[0] += dv[0] * bflo(uu.x); y[1] += dv[1] * bfhi(uu.x); y[2] += dv[2] * bflo(uu.y); y[3] += dv[3] * bfhi(uu.y);
        u32x2 o; o.x = pack2(gelu_t(y[0]), gelu_t(y[1])); o.y = pack2(gelu_t(y[2]), gelu_t(y[3]));
        *(u32x2*)(gyp + (size_t)(row * 16 + tt) * 1024 + g * 16 + lq * 4) = o;
      }
    }
  }
}

__device__ __forceinline__ void ph_ssm_fused(const bf16_t* ugp, const bf16_t* PTp, const bf16_t* YTp, const float* a16p, bf16_t* Xcp,
                                             const float* dskip, bf16_t* gyp, char* smem) {
  LANE_IDS
  float* Sl = (float*)smem;
  for (int t = blockIdx.x; t < 64 * 8; t += gridDim.x) {
    const int g = t >> 3, mt = t & 7, m0 = mt * 256;
    const bf16_t* ugg = ugp + (size_t)g * 2048 * 256;
    {
      RowPlain ar{ugg, 256};
      f32x4 acc[8][4]; zero_acc(acc);
      kloop(acc, ar, PTp + (size_t)g * 128 * 256, 256, m0, 0, 4, smem);
      EPI_IDS
      if (wc < 2) {
#pragma unroll
        for (int m = 0; m < 8; ++m)
#pragma unroll
          for (int n = 0; n < 4; ++n) *(f32x4*)(Sl + ROWL(m) * 128 + COLL(n)) = acc[m][n];
      }
    }
    __syncthreads();
    if (tid < 128) {
      const int bb = tid >> 6, p = tid & 63;
      const float ar_ = a16p[(g * 64 + p) * 2], ai_ = a16p[(g * 64 + p) * 2 + 1];
      float xr = 0.f, xi = 0.f;
      bf16_t* xo = Xcp + ((size_t)(m0 + bb * 128) * 64 + g) * 128;
      const float* sl = Sl + (bb * 128) * 128;
#pragma unroll 8
      for (int c = 0; c < 128; ++c) {
        xo[(size_t)c * 8192 + p] = f2bf(xr); xo[(size_t)c * 8192 + 64 + p] = f2bf(xi);
        const float sr = sl[c * 128 + p], si = sl[c * 128 + 64 + p];
        const float nr = ar_ * xr - ai_ * xi + sr, ni = ar_ * xi + ai_ * xr + si;
        xr = nr; xi = ni;
      }
    }
    __builtin_amdgcn_fence(__ATOMIC_RELEASE, "workgroup");
    asm volatile("s_waitcnt vmcnt(0)" ::: "memory");
    __syncthreads();
    {
      RowSsmY ar{ugg, Xcp + (size_t)g * 128};
      f32x4 acc[8][4]; zero_acc(acc);
      kloop(acc, ar, YTp + (size_t)g * 256 * 384, 384, m0, 0, 6, smem);
      EPI_IDS
      const f32x4 dv = *(const f32x4*)(dskip + g * 16 + lq * 4);
#pragma unroll
      for (int m = 0; m < 8; ++m) {
        asm volatile("" ::: "memory");
        const int row = m0 + ROWL(m);
#pragma unroll
        for (int n = 0; n < 4; ++n) {
          const int tt = wc * 4 + n;
          const u32x2 uu = *(const u32x2*)(ugg + (size_t)row * 256 + tt * 16 + lq * 4);
          f32x4 y = acc[m][n];
          y[0] += dv[0] * bflo(uu.x); y[1] += dv[1] * bfhi(uu.x); y[2] += dv[2] * bflo(uu.y); y[3] += dv[3] * bfhi(uu.y);
          u32x2 o; o.x = pack2(gelu_t(y[0]), gelu_t(y[1])); o.y = pack2(gelu_t(y[2]), gelu_t(y[3]));
          *(u32x2*)(gyp + (size_t)(row * 16 + tt) * 1024 + g * 16 + lq * 4) = o;
        }
      }
    }
  }
}

__device__ __forceinline__ void ph_wglu(const bf16_t* gyp, const bf16_t* Wt, bf16_t* xbp, rss_t* rso, char* smem) {
  LANE_IDS
  RowPlain ar{gyp, 1024};
  for (int t = blockIdx.x; t < 128 * 8; t += gridDim.x) {
    int mt, nt; tile_map(t, 128, 8, mt, nt); const int m0 = mt * 256, n0 = nt * 256;
    f32x4 acc[8][4]; zero_acc(acc);
    kloop(acc, ar, Wt, 1024, m0, n0, 16, smem);
    EPI_IDS
    const int oc = ((n0 + wc * 64) >> 1) + lq * 8;
    u32x4 xq[2];
#pragma unroll
    for (int m = 0; m < 2; ++m) xq[m] = *(const u32x4*)(xbp + (size_t)(m0 + ROWL(m)) * 1024 + oc);
#pragma unroll
    for (int m = 0; m < 8; ++m) {
      const int row = m0 + ROWL(m);
      const size_t rowoff = (size_t)row * 1024;
      asm volatile("" ::: "memory");
      const u32x4 xr = xq[m & 1];
      f32x4 xa = (f32x4){bflo(xr.x), bfhi(xr.x), bflo(xr.y), bfhi(xr.y)}, xc = (f32x4){bflo(xr.z), bfhi(xr.z), bflo(xr.w), bfhi(xr.w)};
#pragma unroll
      for (int r = 0; r < 4; ++r) { xa[r] += acc[m][0][r] * sigm(acc[m][1][r]); xc[r] += acc[m][2][r] * sigm(acc[m][3][r]); }
      u32x4 o; o.x = pack2(xa[0], xa[1]); o.y = pack2(xa[2], xa[3]); o.z = pack2(xc[0], xc[1]); o.w = pack2(xc[2], xc[3]);
      *(u32x4*)(xbp + rowoff + oc) = o;
      float ss = sq4(xa) + sq4(xc);
      if (m + 2 < 8) xq[m & 1] = *(const u32x4*)(xbp + (size_t)(m0 + ROWL(m + 2)) * 1024 + oc);
      ss += __shfl_xor(ss, 16); ss += __shfl_xor(ss, 32);
      if (lq == 0) RSS_ADD(rso + row, ss);
    }
  }
}

__device__ __forceinline__ void ph_resid(const bf16_t* A, int K, const bf16_t* Bt, bf16_t* xbp, rss_t* rso, char* smem) {
  LANE_IDS
  RowPlain ar{A, K};
  for (int t = blockIdx.x; t < 128 * 4; t += gridDim.x) {
    int mt, nt; tile_map(t, 128, 4, mt, nt); const int m0 = mt * 256, n0 = nt * 256;
    f32x4 acc[8][4]; zero_acc(acc);
    kloop(acc, ar, Bt, K, m0, n0, K >> 6, smem);
    EPI_IDS
    u32x4 xq[2][2];
#pragma unroll
    for (int m = 0; m < 2; ++m)
#pragma unroll
      for (int p = 0; p < 2; ++p) xq[m][p] = *(const u32x4*)(xbp + (size_t)(m0 + ROWL(m)) * 1024 + n0 + COLP(p));
#pragma unroll
    for (int m = 0; m < 8; ++m) {
      const int row = m0 + ROWL(m);
      const size_t rowoff = (size_t)row * 1024;
      float ss = 0.f;
      asm volatile("" ::: "memory");
#pragma unroll
      for (int p = 0; p < 2; ++p) {
        const int oc = n0 + COLP(p);
        const u32x4 xr = xq[m & 1][p];
        f32x4 xa = acc[m][2 * p], xc = acc[m][2 * p + 1];
        xa[0] += bflo(xr.x); xa[1] += bfhi(xr.x); xa[2] += bflo(xr.y); xa[3] += bfhi(xr.y);
        xc[0] += bflo(xr.z); xc[1] += bfhi(xr.z); xc[2] += bflo(xr.w); xc[3] += bfhi(xr.w);
        u32x4 o; o.x = pack2(xa[0], xa[1]); o.y = pack2(xa[2], xa[3]); o.z = pack2(xc[0], xc[1]); o.w = pack2(xc[2], xc[3]);
        *(u32x4*)(xbp + rowoff + oc) = o;
        ss += sq4(xa) + sq4(xc);
      }
      if (m + 2 < 8) {
#pragma unroll
        for (int p = 0; p < 2; ++p) xq[m & 1][p] = *(const u32x4*)(xbp + (size_t)(m0 + ROWL(m + 2)) * 1024 + n0 + COLP(p));
      }
      ss += __shfl_xor(ss, 16); ss += __shfl_xor(ss, 32);
      if (lq == 0) RSS_ADD(rso + row, ss);
    }
  }
}

__device__ __forceinline__ void ph_halo_proj(const bf16_t* xbp, const rss_t* rs, const bf16_t* WupTp, float* halop, const bf16_t* pbf, const bf16_t* WpjTp, bf16_t* pj, char* smem) {
  LANE_IDS
  for (int t = blockIdx.x; t < 44; t += gridDim.x) {
    f32x4 acc[8][4]; zero_acc(acc);
    const int nt = t >> 1, kh = t & 1, m0 = 0, n0 = nt * 256;
    RowHalo ar{xbp, kh * 8};
    kloop(acc, ar, WupTp + kh * 512, 1024, m0, n0, 8, smem);
    EPI_IDS
#pragma unroll
    for (int m = 0; m < 8; ++m) {
      const int r = m0 + ROWL(m);
      int tok = 256 * (r >> 1) - 2 + (r & 1); tok = tok < 0 ? 0 : tok;
      const float rstd = RSTD(rs, tok);
#pragma unroll
      for (int n = 0; n < 4; ++n) *(f32x4*)(halop + (size_t)kh * 256 * 5632 + (size_t)r * 5632 + n0 + COLP(n >> 1) + (n & 1) * 4) = acc[m][n] * rstd;
    }
  }
}
__device__ __forceinline__ void ph_proj(const bf16_t* pbf, const bf16_t* WpjTp, bf16_t* pj, char* smem) {
  LANE_IDS
  for (int t = gridDim.x - 1 - blockIdx.x; t < 512; t += gridDim.x) {
    f32x4 acc[8][4]; zero_acc(acc);
    int mt, nt; tile_map(t, 128, 4, mt, nt); const int m0 = mt * 256, n0 = nt * 256;
    RowPlain ar{pbf, 256};
    kloop(acc, ar, WpjTp, 256, m0, n0, 4, smem);
    EPI_IDS
#pragma unroll
    for (int m = 0; m < 8; ++m) {
      const size_t rowoff = (size_t)(m0 + ROWL(m)) * 1024;
#pragma unroll
      for (int p = 0; p < 2; ++p) {
        const f32x4 a0 = acc[m][2 * p], a1 = acc[m][2 * p + 1];
        u32x4 o; o.x = pack2(a0[0], a0[1]); o.y = pack2(a0[2], a0[3]); o.z = pack2(a1[0], a1[1]); o.w = pack2(a1[2], a1[3]);
        *(u32x4*)(pj + rowoff + n0 + COLP(p)) = o;
      }
    }
  }
}

__device__ __forceinline__ void ph_up(const bf16_t* xbp, const rss_t* rs, const bf16_t* WupTp, const float* halop, const float* convw, const float* convb, bf16_t* actp, char* smem) {
  LANE_IDS
  RowPlain ar{xbp, 1024};
  bf16_t* st = (bf16_t*)(smem + 1024);
  for (int t = blockIdx.x; t < 128 * 22; t += gridDim.x) {
    int mt, nt; tile_map(t, 128, 22, mt, nt); const int m0 = mt * 256, n0 = nt * 256;
    f32x4 acc[8][4]; zero_acc(acc);
    kloop(acc, ar, WupTp, 1024, m0, n0, 16, smem);
    EPI_IDS
#pragma unroll
    for (int m = 0; m < 8; ++m) {
      const float rstd = RSTD(rs, m0 + ROWL(m));
#pragma unroll
      for (int p = 0; p < 2; ++p) {
        const f32x4 v0 = acc[m][2 * p] * rstd, v1 = acc[m][2 * p + 1] * rstd;
        u32x4 o; o.x = pack2(v0[0], v0[1]); o.y = pack2(v0[2], v0[3]); o.z = pack2(v1[0], v1[1]); o.w = pack2(v1[2], v1[3]);
        *(u32x4*)(st + (2 + ROWL(m)) * 256 + COLP(p)) = o;
      }
    }
    {
      const int j = tid >> 8, col = tid & 255;
      float hv = 0.f;
      if ((m0 & 2047) != 0) hv = halop[(size_t)(2 * mt + j) * 5632 + n0 + col] + halop[(size_t)256 * 5632 + (size_t)(2 * mt + j) * 5632 + n0 + col];
      st[j * 256 + col] = f2bf(hv);
    }
    __syncthreads();
    {
      const int cp = tid & 31, rg = tid >> 5;
      const int hc = nt * 128 + 4 * cp;
      float wg[3][4], wv[3][4], bg[4], bv[4];
#pragma unroll
      for (int j = 0; j < 3; ++j) {
        const f32x4 a = *(const f32x4*)(convw + j * 5632 + hc), c = *(const f32x4*)(convw + j * 5632 + 2816 + hc);
#pragma unroll
        for (int e = 0; e < 4; ++e) { wg[j][e] = a[e]; wv[j][e] = c[e]; }
      }
      {
        const f32x4 a = *(const f32x4*)(convb + hc), c = *(const f32x4*)(convb + 2816 + hc);
#pragma unroll
        for (int e = 0; e < 4; ++e) { bg[e] = a[e]; bv[e] = c[e]; }
      }
      const int r0 = rg * 16;
      u32x2 g2 = *(const u32x2*)(st + (r0) * 256 + 4 * cp), v2 = *(const u32x2*)(st + (r0) * 256 + 128 + 4 * cp);
      u32x2 g1 = *(const u32x2*)(st + (r0 + 1) * 256 + 4 * cp), v1 = *(const u32x2*)(st + (r0 + 1) * 256 + 128 + 4 * cp);
#pragma unroll 4
      for (int r = 0; r < 16; ++r) {
        const u32x2 g0 = *(const u32x2*)(st + (r0 + r + 2) * 256 + 4 * cp), v0 = *(const u32x2*)(st + (r0 + r + 2) * 256 + 128 + 4 * cp);
        float o4[4];
#pragma unroll
        for (int e = 0; e < 4; ++e) {
          const uint32_t wg2 = (e < 2) ? g2.x : g2.y, wg1 = (e < 2) ? g1.x : g1.y, wg0 = (e < 2) ? g0.x : g0.y;
          const uint32_t wv2 = (e < 2) ? v2.x : v2.y, wv1 = (e < 2) ? v1.x : v1.y, wv0 = (e < 2) ? v0.x : v0.y;
          const float a2 = (e & 1) ? bfhi(wg2) : bflo(wg2), a1 = (e & 1) ? bfhi(wg1) : bflo(wg1), a0 = (e & 1) ? bfhi(wg0) : bflo(wg0);
          const float c2 = (e & 1) ? bfhi(wv2) : bflo(wv2), c1 = (e & 1) ? bfhi(wv1) : bflo(wv1), c0 = (e & 1) ? bfhi(wv0) : bflo(wv0);
          const float cg = bg[e] + wg[0][e] * a2 + wg[1][e] * a1 + wg[2][e] * a0;
          const float cv = bv[e] + wv[0][e] * c2 + wv[1][e] * c1 + wv[2][e] * c0;
          o4[e] = gelu_t(cg) * cv;
        }
        u32x2 o; o.x = pack2(o4[0], o4[1]); o.y = pack2(o4[2], o4[3]);
        *(u32x2*)(actp + (size_t)(m0 + r0 + r) * 2816 + hc) = o;
        g2 = g1; g1 = g0; v2 = v1; v1 = v0;
      }
    }
  }
}

__device__ __forceinline__ void ph_ple(const bf16_t* xbp, const rss_t* rs, const bf16_t* WgtTp, float* xout, bf16_t* xnx, rss_t* rso, bool last, char* smem) {
  LANE_IDS
  RowPlain ar{xbp, 1024};
  for (int t = blockIdx.x; t < 128 * 4; t += gridDim.x) {
    int mt, nt; tile_map(t, 128, 4, mt, nt); const int m0 = mt * 256, n0 = nt * 256;
    f32x4 acc[8][4]; zero_acc(acc);
    kloop(acc, ar, WgtTp, 1024, m0, n0, 16, smem);
    EPI_IDS
    u32x4 xq[2][2], pq[2][2]; float rq[2];
#pragma unroll
    for (int m = 0; m < 2; ++m) {
      rq[m] = RSTD(rs, m0 + ROWL(m));
#pragma unroll
      for (int p = 0; p < 2; ++p) {
        xq[m][p] = *(const u32x4*)(xbp + (size_t)(m0 + ROWL(m)) * 1024 + n0 + COLP(p));
        pq[m][p] = *(const u32x4*)(xnx + (size_t)(m0 + ROWL(m)) * 1024 + n0 + COLP(p));
      }
    }
#pragma unroll
    for (int m = 0; m < 8; ++m) {
      const int row = m0 + ROWL(m);
      const size_t rowoff = (size_t)row * 1024;
      float ss = 0.f;
      asm volatile("" ::: "memory");
      const float rstd = rq[m & 1];
#pragma unroll
      for (int p = 0; p < 2; ++p) {
        const int oc = n0 + COLP(p);
        const u32x4 xr = xq[m & 1][p];
        const u32x4 pp = pq[m & 1][p];
        const f32x4 g0 = acc[m][2 * p], g1 = acc[m][2 * p + 1];
        f32x4 xa, xc;
        xa[0] = bflo(xr.x) + sigm(g0[0] * rstd) * bflo(pp.x);
        xa[1] = bfhi(xr.x) + sigm(g0[1] * rstd) * bfhi(pp.x);
        xa[2] = bflo(xr.y) + sigm(g0[2] * rstd) * bflo(pp.y);
        xa[3] = bfhi(xr.y) + sigm(g0[3] * rstd) * bfhi(pp.y);
        xc[0] = bflo(xr.z) + sigm(g1[0] * rstd) * bflo(pp.z);
        xc[1] = bfhi(xr.z) + sigm(g1[1] * rstd) * bfhi(pp.z);
        xc[2] = bflo(xr.w) + sigm(g1[2] * rstd) * bflo(pp.w);
        xc[3] = bfhi(xr.w) + sigm(g1[3] * rstd) * bfhi(pp.w);
        if (last) { *(f32x4*)(xout + rowoff + oc) = xa; *(f32x4*)(xout + rowoff + oc + 4) = xc; }
        else {
          u32x4 o; o.x = pack2(xa[0], xa[1]); o.y = pack2(xa[2], xa[3]); o.z = pack2(xc[0], xc[1]); o.w = pack2(xc[2], xc[3]);
          *(u32x4*)(xnx + rowoff + oc) = o;
          ss += sq4(xa) + sq4(xc);
        }
      }
      if (m + 2 < 8) {
        rq[m & 1] = RSTD(rs, m0 + ROWL(m + 2));
#pragma unroll
        for (int p = 0; p < 2; ++p) {
          xq[m & 1][p] = *(const u32x4*)(xbp + (size_t)(m0 + ROWL(m + 2)) * 1024 + n0 + COLP(p));
          pq[m & 1][p] = *(const u32x4*)(xnx + (size_t)(m0 + ROWL(m + 2)) * 1024 + n0 + COLP(p));
        }
      }
      if (!last) {
        ss += __shfl_xor(ss, 16); ss += __shfl_xor(ss, 32);
        if (lq == 0) RSS_ADD(rso + row, ss);
      }
    }
  }
}

__device__ __forceinline__ void ph_kvq(const bf16_t* xbp, const rss_t* rs, const bf16_t* Wt, int NT, int coloff, const float* knorm, const float* qnorm,
                       bf16_t* Kbp, bf16_t* Vtp, bf16_t* Qbp, char* smem) {
  LANE_IDS
  RowPlain ar{xbp, 1024};
  const float qscale = 0.125f * 1.4426950408889634f;
  for (int t = blockIdx.x; t < 128 * NT; t += gridDim.x) {
    int mt, nt; tile_map(t, 128, NT, mt, nt); const int m0 = mt * 256, n0 = nt * 256;
    f32x4 acc[8][4]; zero_acc(acc);
    kloop(acc, ar, Wt, 1024, m0, n0, 16, smem);
    EPI_IDS
    const int cw = coloff + n0 + wc * 64;
#pragma unroll
    for (int m = 0; m < 8; ++m) {
      const int tok = m0 + ROWL(m);
      const float rstd = RSTD(rs, tok);
      f32x4 v[4];
      float ss = 0.f;
#pragma unroll
      for (int n = 0; n < 4; ++n) { v[n] = acc[m][n] * rstd; ss += sq4(v[n]); }
      if (cw >= 1024 && cw < 2048) {
        const int b = tok >> 11, tt = tok & 2047;
#pragma unroll
        for (int n = 0; n < 4; ++n)
#pragma unroll
          for (int r = 0; r < 4; ++r) {
            const int j = cw - 1024 + (n >> 1) * 32 + lq * 8 + (n & 1) * 4 + r;
            Vtp[((size_t)(b * 1024 + j)) * 2048 + tt] = f2bf(v[n][r]);
          }
      } else {
        ss += __shfl_xor(ss, 16); ss += __shfl_xor(ss, 32);
        const bool isq = cw >= 2048;
        const float hn = rsqrtf(ss * (1.f / 64.f) + EPSF) * (isq ? qscale : 1.f);
        const float* gn = isq ? qnorm : knorm;
        bf16_t* dst = isq ? (Qbp + (size_t)tok * 1024 + (cw - 2048)) : (Kbp + (size_t)tok * 1024 + cw);
#pragma unroll
        for (int p = 0; p < 2; ++p) {
          const int d0 = p * 32 + lq * 8;
          const f32x4 g0 = *(const f32x4*)(gn + d0), g1 = *(const f32x4*)(gn + d0 + 4);
          const f32x4 a0 = v[2 * p] * hn * g0, a1 = v[2 * p + 1] * hn * g1;
          u32x4 o; o.x = pack2(a0[0], a0[1]); o.y = pack2(a0[2], a0[3]); o.z = pack2(a1[0], a1[1]); o.w = pack2(a1[2], a1[3]);
          *(u32x4*)(dst + d0) = o;
        }
      }
    }
  }
}

#define ATT_COMPUTE(KT_, KST_) do { \
_Pragma("unroll") \
      for (int hf = 0; hf < 2; ++hf) { \
        const int key0 = (KT_) * 64 + hf * 32; \
        if (key0 > q0 + widu * 16 + 15) break;     \
        const char* Ks = KST_ + hf * 32 * 272; \
        const char* Vs = KST_ + 17408 + hf * 64; \
        const bool far = (q0 + widu * 16 - (key0 + 31)) >= 128;       \
        const bool diag = key0 + 31 > q0 + widu * 16;                \
        const float bfar = tab[128]; \
        float bias[2][4]; \
        if (!far) { \
_Pragma("unroll") \
          for (int nf = 0; nf < 2; ++nf) \
_Pragma("unroll") \
            for (int r = 0; r < 4; ++r) { \
              const int dist = qpos - (key0 + lq * 8 + nf * 4 + r); \
              const int idx = dist < 0 ? 0 : (dist > 128 ? 128 : dist); \
              bias[nf][r] = (diag && dist < 0) ? -1e30f : tab[idx]; \
            } \
        } else { \
_Pragma("unroll") \
          for (int nf = 0; nf < 2; ++nf) \
_Pragma("unroll") \
            for (int r = 0; r < 4; ++r) bias[nf][r] = 0.f; \
        } \
        bf16x8 pk[2]; \
_Pragma("unroll") \
        for (int c = 0; c < 2; ++c) { \
            \
          f32x4 sacc[2]; \
_Pragma("unroll") \
          for (int nf = 0; nf < 2; ++nf) { \
            f32x4 a;     \
            if (far) { const float kc = bfar - mb[c]; a = (f32x4){kc, kc, kc, kc}; } \
            else a = (f32x4){bias[nf][0] - mb[c], bias[nf][1] - mb[c], bias[nf][2] - mb[c], bias[nf][3] - mb[c]}; \
_Pragma("unroll") \
            for (int ks = 0; ks < 2; ++ks) { \
              const bf16x8 kf = *(const bf16x8*)(Ks + (8 * (lr >> 2) + 4 * nf + (lr & 3)) * 272 + (c * 64 + ks * 32 + lq * 8) * 2);     \
              a = __builtin_amdgcn_mfma_f32_16x16x32_bf16(kf, qf[c][ks], a, 0, 0, 0); \
            } \
            sacc[nf] = a; \
          } \
_Pragma("unroll") \
          for (int nf = 0; nf < 2; ++nf) \
_Pragma("unroll") \
            for (int r = 0; r < 4; ++r) sacc[nf][r] = __builtin_amdgcn_exp2f(sacc[nf][r]);     \
          union { uint32_t u[4]; bf16x8 v; } cvt; \
          cvt.u[0] = pack2(sacc[0][0], sacc[0][1]); cvt.u[1] = pack2(sacc[0][2], sacc[0][3]); \
          cvt.u[2] = pack2(sacc[1][0], sacc[1][1]); cvt.u[3] = pack2(sacc[1][2], sacc[1][3]); \
          pk[c] = cvt.v; \
        } \
          \
_Pragma("unroll") \
        for (int ef = 0; ef < 8; ++ef) { \
          const bf16x8 vfv = *(const bf16x8*)(Vs + (ef * 16 + lr) * 144 + lq * 16); \
          oacc[0][ef] = __builtin_amdgcn_mfma_f32_16x16x32_bf16(vfv, pk[0], oacc[0][ef], 0, 0, 0); \
          oacc[1][ef] = __builtin_amdgcn_mfma_f32_16x16x32_bf16(vfv, pk[1], oacc[1][ef], 0, 0, 0); \
        } \
          \
        oaccl[0] = __builtin_amdgcn_mfma_f32_16x16x32_bf16(onesf, pk[0], oaccl[0], 0, 0, 0); \
        oaccl[1] = __builtin_amdgcn_mfma_f32_16x16x32_bf16(onesf, pk[1], oaccl[1], 0, 0, 0); \
      } \
      } while (0)
__device__ __forceinline__ void ph_attn(const bf16_t* Qin, bf16_t* Oout, const bf16_t* Kbp, const bf16_t* Vtp, const float* tabgp, const float* knorm, const float* lq1, const float* lk1,
                        const float* lq2, const float* lk2, const float* subln, int Lidx, char* smc) {
  LANE_IDS
  const int lq = lane >> 4, lr = lane & 15;
  const int widu = __builtin_amdgcn_readfirstlane(wid);
  bf16x8 onesf;
#pragma unroll
  for (int e = 0; e < 8; ++e) onesf[e] = (short)0x3F80;
  float* tab = (float*)smc;
  char* stg = smc + 1024;
  float s1 = 0.f, s2 = 0.f, kmax = 0.f;
  for (int d = 0; d < 64; ++d) { s1 += lq1[d] * lk1[d]; s2 += lq2[d] * lk2[d]; kmax = fmaxf(kmax, fabsf(knorm[d])); }
  asm volatile("" : "+s"(Lidx));
  const float lam_init = (Lidx == 2) ? 0.47071302f : 0.55605820f;
  const float lam = expf(s1) - expf(s2) + lam_init;
  const float osc = 1.f - lam_init;
  const float kb = 8.08f * kmax;
  for (int w = blockIdx.x; w < 2048; w += gridDim.x) {
    const int i8 = w & 255, k8 = w >> 8, xcd = i8 & 7, slot = i8 >> 3, jq = slot & 15;
    const int bh = xcd + 8 * (2 * k8 + (slot >> 4));
    const int qb = (k8 & 1) ? (15 - jq) : jq;
    const int b = bh >> 3, h = bh & 7;
    const int q0 = qb * 128, tb = b * 2048;
    const int qpos = q0 + wid * 16 + lr;
    const bf16_t* kbase = Kbp + (size_t)tb * 1024 + h * 128;
    const bf16_t* vbase = Vtp + (size_t)(b * 8 + h) * 128 * 2048;
    const int nkt = 2 * (qb + 1);
    u32x4 kr0[2], vr0[2], kr1[2], vr1[2];
    if (tid < 130) tab[tid] = tabgp[h * 132 + tid];
    bf16x8 qf[2][2];
    float mb[2];
#pragma unroll
    for (int c = 0; c < 2; ++c) {
      float ss = 0.f;
#pragma unroll
      for (int ks = 0; ks < 2; ++ks) {
        const u32x4 qq = *(const u32x4*)(Qin + (size_t)(tb + qpos) * 1024 + h * 128 + c * 64 + ks * 32 + lq * 8);
        union { u32x4 u; bf16x8 v; } cv; cv.u = qq; qf[c][ks] = cv.v;
        ss += bflo(qq.x) * bflo(qq.x) + bfhi(qq.x) * bfhi(qq.x) + bflo(qq.y) * bflo(qq.y) + bfhi(qq.y) * bfhi(qq.y)
            + bflo(qq.z) * bflo(qq.z) + bfhi(qq.z) * bfhi(qq.z) + bflo(qq.w) * bflo(qq.w) + bfhi(qq.w) * bfhi(qq.w);
      }
      ss += __shfl_xor(ss, 16); ss += __shfl_xor(ss, 32);
      mb[c] = sqrtf(ss) * kb;
    }
#define ATT_LOAD(KR, VR, ST) do { _Pragma("unroll") for (int i = 0; i < 2; ++i) { const int v = tid + 512 * i; \
      KR[i] = *(const u32x4*)(kbase + (size_t)((ST) * 64 + (v >> 4)) * 1024 + (v & 15) * 8); \
      VR[i] = *(const u32x4*)(vbase + (size_t)(v >> 3) * 2048 + (ST) * 64 + (v & 7) * 8); } } while (0)
#define ATT_WRITE(KR, VR, BUF) do { char* Kn_ = stg + (BUF) * 35840; _Pragma("unroll") for (int i = 0; i < 2; ++i) { const int v = tid + 512 * i; \
      *(u32x4*)(Kn_ + (v >> 4) * 272 + (v & 15) * 16) = KR[i]; \
      *(u32x4*)(Kn_ + 17408 + (v >> 3) * 144 + (v & 7) * 16) = VR[i]; } } while (0)
    ATT_LOAD(kr0, vr0, 0);
    ATT_LOAD(kr1, vr1, 1);
    ATT_WRITE(kr0, vr0, 0);
    if (nkt > 2) ATT_LOAD(kr0, vr0, 2);
    __syncthreads();
    const float bmax = tab[129];
    mb[0] += bmax; mb[1] += bmax;
    f32x4 oacc[2][8];
#pragma unroll
    for (int c = 0; c < 2; ++c)
#pragma unroll
      for (int e = 0; e < 8; ++e) oacc[c][e] = (f32x4){0.f, 0.f, 0.f, 0.f};
    f32x4 oaccl[2] = {(f32x4){0.f, 0.f, 0.f, 0.f}, (f32x4){0.f, 0.f, 0.f, 0.f}};
    for (int kt = 0; kt < nkt; kt += 2) {
      ATT_COMPUTE(kt, stg);
      ATT_WRITE(kr1, vr1, 1);
      if (kt + 3 < nkt) ATT_LOAD(kr1, vr1, kt + 3);
      __syncthreads();
      ATT_COMPUTE(kt + 1, (stg + 35840));
      if (kt + 2 < nkt) ATT_WRITE(kr0, vr0, 0);
      if (kt + 4 < nkt) ATT_LOAD(kr0, vr0, kt + 4);
      __syncthreads();
    }
#undef ATT_LOAD
#undef ATT_WRITE
    const float l0 = oaccl[0][0], l1 = oaccl[1][0];
    const float i0 = 1.f / l0, i1 = lam / l1;
    float ss = 0.f;
#pragma unroll
    for (int e = 0; e < 8; ++e) {
      oacc[0][e] = oacc[0][e] * i0 - oacc[1][e] * i1;
      ss += sq4(oacc[0][e]);
    }
    ss += __shfl_xor(ss, 16); ss += __shfl_xor(ss, 32);
    const float rn = rsqrtf(ss * (1.f / 128.f) + EPSF) * osc;
#pragma unroll
    for (int e = 0; e < 8; ++e) {
      const f32x4 gv = *(const f32x4*)(subln + e * 16 + lq * 4);
      const f32x4 o = oacc[0][e] * rn * gv;
      u32x2 wv; wv.x = pack2(o[0], o[1]); wv.y = pack2(o[2], o[3]);
      *(u32x2*)(Oout + (size_t)(tb + qpos) * 1024 + h * 128 + e * 16 + lq * 4) = wv;
    }
  }
}

#define XB_TMO      128
#define XB_XCNT(j)  (256  + 64 * (j))
#define XB_XSUB(j)  (1280 + 64 * (j))
#define XB_XGEN(j)  (2304 + 64 * (j))
#define XB_TOP      3328
#define XB_TOPGEN   3392
#define XCD_BAR_WORDS 3456
#define XB_SPIN_CAP (1u << 18)

__device__ __forceinline__ unsigned xb_ld(unsigned* p)              { return __hip_atomic_load(p, __ATOMIC_RELAXED, __HIP_MEMORY_SCOPE_AGENT); }
__device__ __forceinline__ unsigned xb_add(unsigned* p, unsigned v) { return __hip_atomic_fetch_add(p, v, __ATOMIC_RELAXED, __HIP_MEMORY_SCOPE_AGENT); }
__device__ __forceinline__ unsigned xb_xcc_id() { return (unsigned)__builtin_amdgcn_s_getreg((3 << 11) | 20) & 0xFu; }
#define XB_SPIN(cond, bar) do { unsigned _sp = 0; while (cond) { __builtin_amdgcn_s_sleep(1); \
    if ((++_sp & 255u) == 0u) { if (xb_ld(&(bar)[XB_TMO])) break; if (_sp > XB_SPIN_CAP) { atomicAdd(&(bar)[XB_TMO], 1u); break; } } } } while (0)

struct XcdBarrier {
    unsigned* bar; unsigned x;
    volatile LAS unsigned* st;
};

__device__ __forceinline__ XcdBarrier xcd_barrier_post(unsigned* bar, volatile LAS unsigned* st) {
    XcdBarrier b; b.bar = bar; b.x = xb_xcc_id(); b.st = st;
    if (threadIdx.x == 0) (void)xb_add(&bar[XB_XCNT(b.x)], 1u);
    return b;
}
__device__ __forceinline__ void xcd_barrier_complete(unsigned* bar, unsigned x, unsigned& nloc, unsigned& nx) {
    const unsigned G = gridDim.x * gridDim.y * gridDim.z;
    unsigned sum, cnt, mine, sp = 0u;
    for (;;) {
        sum = 0u; cnt = 0u; mine = 0u;
#pragma unroll
        for (unsigned j = 0; j < 16; ++j) { const unsigned c = xb_ld(&bar[XB_XCNT(j)]); sum += c; cnt += (c > 0u) ? 1u : 0u; mine = (j == x) ? c : mine; }
        if (sum == G) break;
        __builtin_amdgcn_s_sleep(1);
        if ((++sp & 255u) == 0u) { if (xb_ld(&bar[XB_TMO])) break; if (sp > XB_SPIN_CAP) { atomicAdd(&bar[XB_TMO], 1u); break; } }
    }
    nloc = mine > 0u ? mine : 1u; nx = cnt > 0u ? cnt : 1u;
}

__device__ __forceinline__ void xcd_barrier(const XcdBarrier& b) {
    asm volatile("s_waitcnt vmcnt(0)" ::: "memory");
    __syncthreads();
    if (threadIdx.x == 0) {
        unsigned* bar = b.bar;
        __builtin_amdgcn_s_waitcnt(0);
        unsigned nloc = b.st[0], nx = b.st[1];
        if (nloc == 0u) { xcd_barrier_complete(bar, b.x, nloc, nx); b.st[0] = nloc; b.st[1] = nx; }
        const unsigned old = xb_add(&bar[XB_XSUB(b.x)], 1u);
        const unsigned gen = old / nloc;
        if (old + 1u == (gen + 1u) * nloc) {
            __builtin_amdgcn_fence(__ATOMIC_RELEASE, "agent");
            asm volatile("s_waitcnt vmcnt(0)" ::: "memory");
            const unsigned og = xb_add(&bar[XB_TOP], 1u);
            const unsigned tg = og / nx;
            if (og + 1u == (tg + 1u) * nx) xb_add(&bar[XB_TOPGEN], 1u);
            else XB_SPIN(xb_ld(&bar[XB_TOPGEN]) == tg, bar);
            __builtin_amdgcn_fence(__ATOMIC_ACQUIRE, "agent");
            xb_add(&bar[XB_XGEN(b.x)], 1u);
            asm volatile("s_waitcnt vmcnt(0)" ::: "memory");
        } else {
            XB_SPIN(xb_ld(&bar[XB_XGEN(b.x)]) == gen, bar);
            __builtin_amdgcn_fence(__ATOMIC_ACQUIRE, "agent");
            asm volatile("s_waitcnt vmcnt(0)" ::: "memory");
        }
    }
    __syncthreads();
}

#define PHASE_PTRS int z = 0; asm volatile("" : "+s"(z)); char* ws = P.ws + z; const float* const* in = P.in + z; float* x = P.out + z; (void)ws; (void)in; (void)x;
#define WinT ((bf16_t*)(ws + OFF_WIN))
#define WgluT ((bf16_t*)(ws + OFF_WGLU))
#define PT ((bf16_t*)(ws + OFF_PT))
#define YT ((bf16_t*)(ws + OFF_YT))
#define WkvqT ((bf16_t*)(ws + OFF_WKVQ))
#define WoT ((bf16_t*)(ws + OFF_WO))
#define WupT ((bf16_t*)(ws + OFF_WUP))
#define WdnT ((bf16_t*)(ws + OFF_WDN))
#define WgtT ((bf16_t*)(ws + OFF_WGT))
#define WpjT ((bf16_t*)(ws + OFF_WPJ))
#define a16 ((float*)(ws + OFF_SMALL))
#define tabg ((float*)(ws + OFF_SMALL + 65536))
#define SSMC ((float*)(ws + OFF_SMALL + 3584 * 1024))
#define OFF_BAR (OFF_SMALL + 3840 * 1024)
#define ROWSS(v) ((rss_t*)(ws + OFF_SMALL + 131072) + (size_t)(v) * 32768)
#define PBF ((bf16_t*)(ws + OFF_PBF))
#define XBCUR ((bf16_t*)(ws + ((L & 1) ? OFF_XB1 : OFF_XB0)))
#define XBNXT ((bf16_t*)(ws + ((L & 1) ? OFF_XB0 : OFF_XB1)))
#define ug ((bf16_t*)(ws + OFF_UG))
#define S_ ((float*)(ws + OFF_S))
#define Xc ((bf16_t*)(ws + OFF_XC))
#define gy ((bf16_t*)(ws + OFF_GY))
#define Kb ((bf16_t*)(ws + OFF_K))
#define Vt ((bf16_t*)(ws + OFF_VT))
#define QO ((bf16_t*)(ws + OFF_QO))
#define act ((bf16_t*)(ws + OFF_ACT))
#define halo ((float*)(ws + OFF_HALO))
__global__ void __launch_bounds__(NTHR, 2) yoco_mega(Params P) {
  extern __shared__ __attribute__((aligned(1024))) char smraw[];
  float* smf = (float*)smraw;
  volatile LAS unsigned* bst = (volatile LAS unsigned*)(LAS char*)(smraw + 139200);
  if (threadIdx.x == 0) { bst[0] = 0u; bst[1] = 0u; }
  __syncthreads();
  XcdBarrier gbar; gbar.bar = (unsigned*)(P.ws + OFF_BAR); gbar.x = 0; gbar.st = bst;
  if (P.coop) gbar = xcd_barrier_post((unsigned*)(P.ws + OFF_BAR), bst);
  if (P.ph_lo == 0 && blockIdx.x < 64) {
    PHASE_PTRS
    int tid_ = threadIdx.x; asm volatile("" : "+v"(tid_));
    if (tid_ < 128) ssm_consts(in[4], in[5], in[6], SSMC, a16, tid_ >> 6, blockIdx.x, tid_ & 63);
    __threadfence();
  }
  for (int ph = P.ph_lo; ph < P.ph_hi; ++ph) {
    const int L = ph / 10, s = ph % 10;
    const bool isA = L < 2;
    const int j = L - 2;
    const int nrep = ((REPMASK >> s) & 1) ? 2 : 1;
    for (int rep = 0; rep < nrep; ++rep) {
    if ((s == 0 && L == 0) || (s == 9 && L < 3)) {
      PHASE_PTRS
      const int LP = (s == 0) ? 0 : L + 1;
      const bool pA = LP < 2; const int jp = LP - 2;
      if (s == 9) ph_ple(XBCUR, ROWSS(3 * L + 2), WgtT, x, XBNXT, ROWSS(3 * L + 3), false, smraw);
      if (LP == 0) prep_x(in[0], (bf16_t*)(ws + OFF_XB0), ROWSS(0));
      prep_p(in[1] + (size_t)LP * 32768 * 256, PBF);
      if (pA) prep_ssm(SSMC + (size_t)LP * 16384, in[7] + (size_t)LP * 65536, in[8] + (size_t)LP * 65536,
                       in[9] + (size_t)LP * 65536, in[10] + (size_t)LP * 65536, PT, YT, smf);
      else if (jp == 0) prep_bias(in[25], tabg);
#pragma unroll 1
      for (int mi = 0; mi < 7; ++mi) {
        const float* src = nullptr; const float* gain = nullptr; bf16_t* dst = nullptr; int K = 1024, N = 1024, Nsub = 1024, mode = 0;
        if (mi == 0) { src = in[27] + (size_t)LP * 1024 * 5632; N = 5632; Nsub = 5632; dst = WupT; gain = in[26] + LP * 1024; mode = 2; }
        else if (mi == 1) { src = in[30] + (size_t)LP * 2816 * 1024; K = 2816; dst = WdnT; mode = 3; }
        else if (mi == 2) { if (LP != 0) continue; src = in[32]; dst = WgtT; gain = in[31]; mode = 3; }
        else if (mi == 3) { src = in[33] + (size_t)LP * 256 * 1024; K = 256; dst = WpjT; mode = 3; }
        else if (pA) {
          if (mi == 4) { src = in[3] + (size_t)LP * 1024 * 1024; dst = WinT; gain = in[2] + LP * 1024; mode = 3; }
          else if (mi == 5) { src = in[12] + (size_t)LP * 1024 * 2048; N = 2048; Nsub = 2048; dst = WgluT; mode = 1; }
          else continue;
        } else {
          if (mi == 4) { src = in[24] + (size_t)jp * 1024 * 1024; dst = WoT; mode = 3; }
          else if (mi == 5) { src = in[17] + (size_t)jp * 1024 * 1024; dst = WkvqT + (jp == 0 ? (size_t)2048 * 1024 : 0); gain = in[16] + jp * 1024; mode = 3; }
          else if (jp == 0) { src = in[14]; N = 2048; Nsub = 2048; dst = WkvqT; gain = in[13]; mode = 3; }
          else continue;
        }
        prep_mat(src, K, N, Nsub, dst, gain, mode, smf);
      }
    } else if (s == 1) {
      PHASE_PTRS
      if (isA) ph_win(XBCUR, ROWSS(3 * L), WinT, ug, smraw);
      else ph_kvq(XBCUR, ROWSS(3 * L), WkvqT, j == 0 ? 12 : 4, j == 0 ? 0 : 2048, in[15], in[18] + j * 64, Kb, Vt, QO, smraw);
      if (L >= 1) prep_mat(in[32] + (size_t)L * 1024 * 1024, 1024, 1024, 1024, WgtT, in[31] + L * 1024, 3, smf);
    } else if (s == 2) {
      PHASE_PTRS
      if (isA) ph_ssm_fused(ug, PT, YT, a16 + (size_t)L * 8192, Xc, in[11] + L * 1024, gy, smraw);
      else ph_attn(QO, (rep + 1 < nrep) ? (bf16_t*)(ws + 400 * MIB) : QO, Kb, Vt, tabg, in[15], in[19] + j * 64, in[20] + j * 64, in[21] + j * 64, in[22] + j * 64, in[23] + j * 128,
                   L, smraw);
    } else if (s == 3) {
      PHASE_PTRS
      ;
    } else if (s == 4) {
      PHASE_PTRS
      ;
    } else if (s == 5) {
      PHASE_PTRS
      if (isA) ph_wglu(gy, WgluT, XBCUR, ROWSS(3 * L + 1), smraw);
    } else if (s == 6) {
      PHASE_PTRS
      ph_halo_proj(XBCUR, ROWSS(3 * L + 1), WupT, halo, PBF, WpjT, XBNXT, smraw);
      ph_proj(PBF, WpjT, XBNXT, smraw);
    } else if (s == 7) {
      PHASE_PTRS
      ph_up(XBCUR, ROWSS(3 * L + 1), WupT, halo, in[28] + (size_t)L * 3 * 5632, in[29] + (size_t)L * 5632, act, smraw);
    } else if (s == 9) {
      PHASE_PTRS
      ph_ple(XBCUR, ROWSS(3 * L + 2), WgtT, x, XBNXT, ROWSS(3 * L + 3), true, smraw);
    }
    if (nrep > 1 && rep == 0 && P.coop) xcd_barrier(gbar);
    }
    if ((s == 3 && !isA) || s == 8) {
      PHASE_PTRS
      const bool dn = s == 8;
      ph_resid(dn ? act : QO, dn ? 2816 : 1024, dn ? WdnT : WoT, XBCUR, ROWSS(3 * L + (dn ? 2 : 1)), smraw);
    }
    if (P.coop && ph + 1 < P.ph_hi && !(!isA && (s == 4 || s == 5)) && !(isA && (s == 3 || s == 4)) && !(s == 0 && L > 0)) {
      if (P.coop == 2) cg::this_grid().sync();
      xcd_barrier(gbar);
      if (REPMASK & 1024) xcd_barrier(gbar);
    }
  }
}

extern "C" void kernel_launch(void* const* d_in, const int* in_sizes, int n_in, void* d_out, int out_size, void* d_ws, size_t ws_size,
                              hipStream_t stream) {
  static int grid_blocks = 0;
  if (!grid_blocks) {
    int dev = 0, cus = 0, per_cu = 0;
    (void)hipGetDevice(&dev);
    (void)hipDeviceGetAttribute(&cus, hipDeviceAttributeMultiprocessorCount, dev);
    if (hipFuncSetAttribute((const void*)yoco_mega, hipFuncAttributeMaxDynamicSharedMemorySize, LDS_BYTES) != hipSuccess)
      fprintf(stderr, "hipFuncSetAttribute(MaxDynamicSharedMemorySize) failed\n");
    (void)hipOccupancyMaxActiveBlocksPerMultiprocessor(&per_cu, (const void*)yoco_mega, NTHR, LDS_BYTES);
    if (per_cu < 1) { fprintf(stderr, "occupancy query says %d blocks/CU\n", per_cu); per_cu = 1; }
    if (per_cu > 1) per_cu = 1;
    grid_blocks = cus * per_cu;
    if (ws_size < WS_NEED) fprintf(stderr, "workspace too small: %zu < %llu\n", ws_size, (unsigned long long)WS_NEED);
  }
  Params P;
  memset(&P, 0, sizeof(P));
  for (int i = 0; i < 34; ++i) P.in[i] = (const float*)d_in[i];
  P.out = (float*)d_out;
  P.ws = (char*)d_ws;
#if MK_SINGLE
  P.ph_lo = 0; P.ph_hi = 40; P.coop = 1;
  (void)hipMemsetAsync((char*)d_ws + OFF_BAR, 0, XCD_BAR_WORDS * 4, stream);
  void* args[] = {&P};
  hipError_t e = hipLaunchCooperativeKernel((void*)yoco_mega, dim3(grid_blocks), dim3(NTHR), args, LDS_BYTES, stream);
  if (e != hipSuccess) fprintf(stderr, "cooperative launch failed: %s (grid %d)\n", hipGetErrorString(e), grid_blocks);
#else
  for (int ph = 0; ph < 40; ++ph) {
    const int L = ph / 10, s = ph % 10;
    if (L >= 2 && (s == 4 || s == 5)) continue;
    P.ph_lo = ph; P.ph_hi = ph + 1; P.coop = 0;
    hipLaunchKernelGGL(yoco_mega, dim3(grid_blocks), dim3(NTHR), LDS_BYTES, stream, P);
  }
#endif
}
```

```cpp
#include <hip/hip_runtime.h>
#include <hip/hip_cooperative_groups.h>
#include <stdint.h>
#include <stdio.h>
#include <string.h>
namespace cg = cooperative_groups;

typedef unsigned short bf16_t;
typedef short bf16x8 __attribute__((ext_vector_type(8)));
typedef float f32x4 __attribute__((ext_vector_type(4)));
typedef unsigned int u32x4 __attribute__((ext_vector_type(4)));
typedef unsigned int u32x2 __attribute__((ext_vector_type(2)));
typedef unsigned long long rss_t;
#define RSS_SCALE 16777216.f
#define LAS __attribute__((address_space(3)))

#ifndef REPMASK
#define REPMASK 0
#endif
#ifndef MK_SINGLE
#define MK_SINGLE 1
#endif

#define NTHR 512
#define LDS_BYTES 139264
#define EPSF 1e-6f
#define MIB (1ull << 20)
#define OFF_WIN  (0 * MIB)
#define OFF_WGLU (2 * MIB)
#define OFF_PT   (6 * MIB)
#define OFF_YT   (10 * MIB)
#define OFF_WKVQ (0 * MIB)
#define OFF_WO   (6 * MIB)
#define OFF_WUP  (22 * MIB)
#define OFF_WDN  (33 * MIB)
#define OFF_WGT  (39 * MIB)
#define OFF_WPJ  (41 * MIB)
#define OFF_SMALL (42 * MIB)
#define OFF_PBF  (46 * MIB)
#define OFF_XB0  (62 * MIB)
#define OFF_XB1  (126 * MIB)
#define OFF_UG   (190 * MIB)
#define OFF_S    (254 * MIB)
#define OFF_XC   (318 * MIB)
#define OFF_GY   (350 * MIB)
#define OFF_K    (190 * MIB)
#define OFF_VT   (254 * MIB)
#define OFF_QO   (318 * MIB)
#define OFF_ACT  (318 * MIB)
#define OFF_HALO (494 * MIB)
#define WS_NEED  (505 * MIB)

struct Params {
  const float* in[34];
  float* out;
  char* ws;
  int ph_lo, ph_hi, coop, pad;
};

__device__ __forceinline__ bf16_t f2bf(float f) {
  uint32_t u = __float_as_uint(f);
  u += 0x7fffu + ((u >> 16) & 1u);
  return (bf16_t)(u >> 16);
}
typedef __bf16 bf16v2 __attribute__((ext_vector_type(2)));
__device__ __forceinline__ uint32_t pack2(float a, float b) { bf16v2 v; v[0] = (__bf16)a; v[1] = (__bf16)b; return __builtin_bit_cast(uint32_t, v); }
__device__ __forceinline__ float bflo(uint32_t u) { return __uint_as_float(u << 16); }
__device__ __forceinline__ float bfhi(uint32_t u) { return __uint_as_float(u & 0xffff0000u); }
__device__ __forceinline__ float gelu_t(float x) {
  const float t = x * x;
  const float e = __builtin_amdgcn_exp2f(x * (-2.302208198f - 0.1029432397f * t));
  return x * __builtin_amdgcn_rcpf(1.f + e);
}
__device__ __forceinline__ float sigm(float x) { return __builtin_amdgcn_rcpf(1.f + __builtin_amdgcn_exp2f(-1.4426950408889634f * x)); }
__device__ __forceinline__ float sq4(f32x4 v) { return v[0] * v[0] + v[1] * v[1] + v[2] * v[2] + v[3] * v[3]; }

struct RowPlain {
  const bf16_t* A; int lda;
  __device__ __forceinline__ const char* base(int kt) const { return (const char*)(A + kt * 64); }
  __device__ __forceinline__ unsigned off(int row, int kt) const { return (unsigned)row * (unsigned)(lda * 2); }
};
struct RowHalo {
  const bf16_t* A; int ko;
  __device__ __forceinline__ const char* base(int kt) const { return (const char*)(A + (kt + ko) * 64); }
  __device__ __forceinline__ unsigned off(int row, int kt) const {
    int tok = 256 * (row >> 1) - 2 + (row & 1); tok = tok < 0 ? 0 : tok;
    return (unsigned)tok * 2048u;
  }
};
struct RowSsmY {
  const bf16_t* ugg; const bf16_t* xcg;
  __device__ __forceinline__ const char* base(int kt) const { return kt < 4 ? (const char*)(ugg + kt * 64) : (const char*)(xcg + (kt - 4) * 64); }
  __device__ __forceinline__ unsigned off(int row, int kt) const { return ((unsigned)row * 512u) << (kt < 4 ? 0 : 5); }
};

__device__ __forceinline__ const char* uni_ptr(const char* p) {
  const unsigned long long u = (unsigned long long)p;
  const unsigned lo = __builtin_amdgcn_readfirstlane((unsigned)u), hi = __builtin_amdgcn_readfirstlane((unsigned)(u >> 32));
  return (const char*)(((unsigned long long)hi << 32) | lo);
}
__device__ __forceinline__ int lds_byte(int r, int c) {
  const int st = (r >> 4) * 2 + (c >> 5), ob = (r & 15) * 64 + (c & 31) * 2;
  return st * 1024 + (ob ^ (((ob >> 9) & 1) << 5));
}
__device__ __forceinline__ void stage_rc(int b, int& R, int& C) {
  const int st = b >> 10, sb = b & 1023, swz = sb ^ (((sb >> 9) & 1) << 5);
  R = (st >> 1) * 16 + swz / 64;
  C = (st & 1) * 32 + (swz % 64) / 2;
}

template <class AR>
__device__ __forceinline__ void kloop(f32x4 (&acc)[8][4], const AR& ar, const bf16_t* __restrict__ Bt, int ldb, int m0, int n0, int nt, char* smem) {
  int tid_ = threadIdx.x; asm volatile("" : "+v"(tid_));
  const int tid = tid_, wid = tid >> 6, lane = tid & 63, wr = wid >> 2, wc = wid & 3, fr = lane & 15, fq = lane >> 4;
  int sR, sC; stage_rc(wid * 1024 + lane * 16, sR, sC);
  const unsigned sC2 = (unsigned)sC * 2u;
  const unsigned bo0 = ((unsigned)(n0 + sR) * (unsigned)ldb + (unsigned)sC) * 2u;
  const size_t bstep = (size_t)ldb * 128u;
  const int ar0 = m0 + sR;
  const unsigned ldsw = __builtin_amdgcn_readfirstlane((unsigned)(size_t)smem + (unsigned)wid * 1024u);
  __syncthreads();
#define GLDS16(ldsaddr, voff, sbase) asm volatile("s_mov_b32 m0, %0\n\tglobal_load_lds_dwordx4 %1, %2" :: "s"(ldsaddr), "v"(voff), "s"(sbase) : "memory")
#define GSTAGE(buf, kt) do { const char* ab_ = uni_ptr(ar.base(kt)); const char* bb_ = uni_ptr((const char*)(Bt + (kt) * 64)); _Pragma("unroll") for (int i = 0; i < 4; ++i) { \
    GLDS16(ldsw + (unsigned)((buf) * 65536 + i * 8192), ar.off(ar0 + 64 * i, (kt)) + sC2, ab_); \
    GLDS16(ldsw + (unsigned)((buf) * 65536 + 32768 + i * 8192), bo0, bb_ + bstep * i); } } while (0)
  GSTAGE(0, 0);
  asm volatile("s_waitcnt vmcnt(0)" ::: "memory");
  __syncthreads();
#pragma unroll 1
  for (int t = 0; t < nt; ++t) {
    const int cur = t & 1;
    if (t + 1 < nt) GSTAGE(cur ^ 1, t + 1);
    const char* sA = smem + cur * 65536;
    const char* sB = sA + 32768;
#pragma unroll
    for (int ks = 0; ks < 2; ++ks) {
      bf16x8 Bf[4], At[8];
#pragma unroll
      for (int n = 0; n < 4; ++n) Bf[n] = *(const bf16x8*)(sB + lds_byte(wc * 64 + n * 16 + fr, ks * 32 + fq * 8));
#pragma unroll
      for (int m = 0; m < 8; ++m) At[m] = *(const bf16x8*)(sA + lds_byte(wr * 128 + m * 16 + fr, ks * 32 + fq * 8));
#pragma unroll
      for (int m = 0; m < 8; ++m)
#pragma unroll
        for (int n = 0; n < 4; ++n) acc[m][n] = __builtin_amdgcn_mfma_f32_16x16x32_bf16(Bf[n], At[m], acc[m][n], 0, 0, 0);
      __builtin_amdgcn_sched_group_barrier(0x100, 8, 0);
      __builtin_amdgcn_sched_group_barrier(0x008, 4, 0);
      __builtin_amdgcn_sched_group_barrier(0x100, 2, 0);
      __builtin_amdgcn_sched_group_barrier(0x008, 4, 0);
      __builtin_amdgcn_sched_group_barrier(0x100, 2, 0);
      __builtin_amdgcn_sched_group_barrier(0x008, 24, 0);
      __builtin_amdgcn_sched_barrier(0);
    }
    asm volatile("s_waitcnt vmcnt(0)" ::: "memory");
    __syncthreads();
  }
#undef GSTAGE
#undef GLDS16
}

__device__ __forceinline__ void tile_map(int L, int nM, int nN, int& pm, int& pn) {
  const int q = (nM * nN) >> 3;
  const int wgid = (L & 7) * q + (L >> 3);
  const int nig = 8 * nN, gid = wgid / nig, r = wgid - gid * nig;
  pm = gid * 8 + (r & 7); pn = r >> 3;
}
__device__ __forceinline__ void zero_acc(f32x4 (&acc)[8][4]) {
#pragma unroll
  for (int m = 0; m < 8; ++m)
#pragma unroll
    for (int n = 0; n < 4; ++n) acc[m][n] = (f32x4){0.f, 0.f, 0.f, 0.f};
}

__device__ __forceinline__ int srccol(int n, int mode) {
  if (mode == 1) { const int q64 = n >> 6, f = (n >> 4) & 3, i = n & 15; const int oc = 32 * q64 + 8 * (i >> 2) + 4 * (f >> 1) + (i & 3);
                   return (f & 1) ? 1024 + oc : oc; }
  if (mode == 2) { const int rho = n & 31, nn = rho >> 4, i = rho & 15; const int np = (n & ~31) + 8 * (i >> 2) + 4 * nn + (i & 3);
                   const int nt = np >> 8, j = np & 255; return j < 128 ? nt * 128 + j : 2816 + nt * 128 + (j - 128); }
  if (mode == 3) { const int rho = n & 31, nn = rho >> 4, i = rho & 15; return (n & ~31) + 8 * (i >> 2) + 4 * nn + (i & 3); }
  return n;
}
__device__ __forceinline__ void prep_mat(const float* __restrict__ src, int K, int N, int Nsub, bf16_t* __restrict__ dst, const float* __restrict__ gain, int mode, float* smf) {
  int tid_ = threadIdx.x; asm volatile("" : "+v"(tid_)); const int tid = tid_;
  const int KT = K >> 6, NT = Nsub >> 6, ntile = KT * NT;
  const int j = tid & 63, kq = tid >> 6;
  float v[8];
  int t = blockIdx.x;
  if (t < ntile) {
    const int k0 = (t % KT) * 64, n0 = (t / KT) * 64; const int sc = srccol(n0 + j, mode);
#pragma unroll
    for (int i = 0; i < 8; ++i) { const int k = i * 8 + kq; v[i] = src[(size_t)(k0 + k) * N + sc] * (gain ? gain[k0 + k] : 1.f); }
  }
  for (; t < ntile; t += gridDim.x) {
    const int k0 = (t % KT) * 64, n0 = (t / KT) * 64;
    __syncthreads();
#pragma unroll
    for (int i = 0; i < 8; ++i) smf[(i * 8 + kq) * 65 + j] = v[i];
    const int tn = t + gridDim.x;
    if (tn < ntile) {
      const int k1 = (tn % KT) * 64, n1 = (tn / KT) * 64; const int sc = srccol(n1 + j, mode);
#pragma unroll
      for (int i = 0; i < 8; ++i) { const int k = i * 8 + kq; v[i] = src[(size_t)(k1 + k) * N + sc] * (gain ? gain[k1 + k] : 1.f); }
    }
    __syncthreads();
    {
      const int row = tid >> 3, kv = tid & 7;
      float w[8];
#pragma unroll
      for (int e = 0; e < 8; ++e) w[e] = smf[(kv * 8 + e) * 65 + row];
      u32x4 o; o.x = pack2(w[0], w[1]); o.y = pack2(w[2], w[3]); o.z = pack2(w[4], w[5]); o.w = pack2(w[6], w[7]);
      *(u32x4*)(dst + (size_t)(n0 + row) * K + k0 + kv * 8) = o;
    }
  }
}

__device__ __forceinline__ void ssm_consts(const float* log_dt, const float* lam_re, const float* lam_im, float* ssmc, float* a16p, int L, int g, int p) {
  const float dt = expf(log_dt[L * 64 + g]);
  const float lr = lam_re[L * 4096 + g * 64 + p], li = lam_im[L * 4096 + g * 64 + p];
  const float mag = expf(lr * dt);
  const float abr = mag * cosf(li * dt), abi = mag * sinf(li * dt);
  const float den = lr * lr + li * li;
  const float fr = ((abr - 1.f) * lr + abi * li) / den;
  const float fi = (abi * lr - (abr - 1.f) * li) / den;
  *(f32x4*)(ssmc + (size_t)((L * 64 + g) * 64 + p) * 4) = (f32x4){abr, abi, fr, fi};
  float xr = abr, xi = abi;
#pragma unroll
  for (int q = 0; q < 4; ++q) { float nr = xr * xr - xi * xi, ni = 2.f * xr * xi; xr = nr; xi = ni; }
  a16p[(size_t)L * 8192 + (g * 64 + p) * 2] = xr; a16p[(size_t)L * 8192 + (g * 64 + p) * 2 + 1] = xi;
}

__device__ __forceinline__ void prep_ssm(const float* ssmcL, const float* b_re, const float* b_im,
                         const float* c_re, const float* c_im, bf16_t* PT, bf16_t* YT, float* smf) {
  int tid_ = threadIdx.x; asm volatile("" : "+v"(tid_)); const int tid = tid_;
  float* s_abr = smf; float* s_abi = smf + 64; float* s_fr = smf + 128; float* s_fi = smf + 192;
  float* s_pr = smf + 256; float* s_pi = smf + 320;
  for (int g = blockIdx.x; g < 64; g += gridDim.x) {
    __syncthreads();
    if (tid < 64) {
      const f32x4 cc = *(const f32x4*)(ssmcL + (size_t)(g * 64 + tid) * 4);
      s_abr[tid] = cc[0]; s_abi[tid] = cc[1]; s_fr[tid] = cc[2]; s_fi[tid] = cc[3];
      s_pr[tid] = 1.f; s_pi[tid] = 0.f;
    }
    __syncthreads();
    if (tid < 256) {
      const int co = tid >> 4, ci = tid & 15;
      bf16_t* yg = YT + (size_t)g * 256 * 384;
      float kj[16];
#pragma unroll
      for (int j = 0; j < 16; ++j) kj[j] = 0.f;
#pragma unroll 2
      for (int p = 0; p < 64; ++p) {
        const float br = b_re[(g * 64 + p) * 16 + ci], bi = b_im[(g * 64 + p) * 16 + ci];
        const float fr = s_fr[p], fi = s_fi[p], ar = s_abr[p], ai = s_abi[p];
        const float bbr = fr * br - fi * bi, bbi = fr * bi + fi * br;
        const float cr = c_re[(g * 16 + co) * 64 + p], cim = c_im[(g * 16 + co) * 64 + p];
        float zr = cr * bbr - cim * bbi, zi = cr * bbi + cim * bbr;
#pragma unroll
        for (int j = 0; j < 16; ++j) { kj[j] += zr; const float nr = zr * ar - zi * ai, ni = zr * ai + zi * ar; zr = nr; zi = ni; }
      }
#pragma unroll
      for (int j = 0; j < 16; ++j) {
        const bf16_t v = f2bf(kj[j]);
#pragma unroll 1
        for (int t = j; t < 16; ++t) yg[(t * 16 + co) * 384 + (t - j) * 16 + ci] = v;
        if (j > 0) {
#pragma unroll 1
          for (int t = 0; t + j < 16; ++t) yg[(t * 16 + co) * 384 + (t + j) * 16 + ci] = 0;
        }
      }
    }
    {
      bf16_t* yg = YT + (size_t)g * 256 * 384;
#pragma unroll 1
      for (int i = 0; i < 2; ++i) {
        const int idx = tid + 512 * i, co = idx >> 6, p = idx & 63;
        const float ar = s_abr[p], ai = s_abi[p];
        float zr = c_re[(g * 16 + co) * 64 + p], zi = c_im[(g * 16 + co) * 64 + p];
#pragma unroll 1
        for (int t = 0; t < 16; ++t) {
          const float nr = zr * ar - zi * ai, ni = zr * ai + zi * ar; zr = nr; zi = ni;
          yg[(t * 16 + co) * 384 + 256 + p] = f2bf(zr);
          yg[(t * 16 + co) * 384 + 320 + p] = f2bf(-zi);
        }
      }
    }
    {
      bf16_t* pg = PT + (size_t)g * 128 * 256;
#pragma unroll 1
      for (int i = 0; i < 2; ++i) {
        const int idx = tid + 512 * i, p = idx >> 4, c = idx & 15;
        const float ar = s_abr[p], ai = s_abi[p], fr = s_fr[p], fi = s_fi[p];
        const float br = b_re[(g * 64 + p) * 16 + c], bi = b_im[(g * 64 + p) * 16 + c];
        float zr = fr * br - fi * bi, zi = fr * bi + fi * br;
#pragma unroll 1
        for (int t = 15; t >= 0; --t) {
          pg[p * 256 + t * 16 + c] = f2bf(zr);
          pg[(64 + p) * 256 + t * 16 + c] = f2bf(zi);
          const float nr = zr * ar - zi * ai, ni = zr * ai + zi * ar; zr = nr; zi = ni;
        }
      }
    }
  }
}

__device__ __forceinline__ void prep_bias(const float* rel_bias, float* tab) {
  if (blockIdx.x == 0) {
    int tid_ = threadIdx.x; asm volatile("" : "+v"(tid_));
    for (int idx = tid_; idx < 8 * 129; idx += NTHR) {
      const int h = idx / 129, n = idx % 129;
      int bucket;
      if (n < 16) bucket = n;
      else {
        bucket = 16 + (n >= 19) + (n >= 21) + (n >= 24) + (n >= 27) + (n >= 31) + (n >= 35) + (n >= 40) + (n >= 46) + (n >= 52) + (n >= 59)
                 + (n >= 67) + (n >= 77) + (n >= 87) + (n >= 99) + (n >= 113);
      }
      tab[h * 132 + n] = rel_bias[bucket * 8 + h] * 1.4426950408889634f;
    }
    if (tid_ < 8) {
      float mx = -1e30f;
      for (int bk = 0; bk < 32; ++bk) mx = fmaxf(mx, rel_bias[bk * 8 + tid_] * 1.4426950408889634f);
      tab[tid_ * 132 + 129] = mx;
    }
  }
}

__device__ __forceinline__ void prep_x(const float* xin, bf16_t* xbuf, rss_t* rowss) {
  int tid_ = threadIdx.x; asm volatile("" : "+v"(tid_)); const int tid = tid_, wid = tid >> 6, lane = tid & 63;
  for (int i = blockIdx.x * NTHR + tid; i < 12 * 32768; i += gridDim.x * NTHR) rowss[32768 + i] = 0ull;
#pragma unroll 2
  for (int row = blockIdx.x * 8 + wid; row < 32768; row += gridDim.x * 8) {
    float ss = 0.f;
#pragma unroll
    for (int i = 0; i < 2; ++i) {
      const f32x4* p = (const f32x4*)(xin + (size_t)row * 1024 + i * 512 + lane * 8);
      const f32x4 a = p[0], b = p[1];
      u32x4 o; o.x = pack2(a[0], a[1]); o.y = pack2(a[2], a[3]); o.z = pack2(b[0], b[1]); o.w = pack2(b[2], b[3]);
      *(u32x4*)(xbuf + (size_t)row * 1024 + i * 512 + lane * 8) = o;
      ss += sq4(a) + sq4(b);
    }
#pragma unroll
    for (int o = 32; o >= 1; o >>= 1) ss += __shfl_xor(ss, o);
    if (lane == 0) rowss[row] = (rss_t)(ss * RSS_SCALE + 0.5f);
  }
}
__device__ __forceinline__ void prep_p(const float* pin, bf16_t* pbf) {
  int tid_ = threadIdx.x; asm volatile("" : "+v"(tid_));
#pragma unroll 4
  for (size_t i = (size_t)blockIdx.x * NTHR + tid_; i < (size_t)32768 * 256 / 8; i += (size_t)gridDim.x * NTHR) {
    const f32x4* p = (const f32x4*)(pin + i * 8);
    const f32x4 a = p[0], b = p[1];
    u32x4 o; o.x = pack2(a[0], a[1]); o.y = pack2(a[2], a[3]); o.z = pack2(b[0], b[1]); o.w = pack2(b[2], b[3]);
    *(u32x4*)(pbf + i * 8) = o;
  }
}

#define ROWL(m) (wr * 128 + (m) * 16 + lr)
#define COLL(n) (wc * 64 + (n) * 16 + lq * 4)
#define COLP(p) (wc * 64 + (p) * 32 + lq * 8)
#define LANE_IDS int tid_ = threadIdx.x; asm volatile("" : "+v"(tid_)); const int tid = tid_, lane = tid & 63, wid = tid >> 6, wr = wid >> 2, wc = wid & 3; (void)tid; (void)lane; (void)wr; (void)wc;
#define EPI_IDS int lq = lane >> 4, lr = lane & 15; asm volatile("" : "+v"(lq), "+v"(lr));
#define RSTD(rs, row) rsqrtf((float)(rs)[row] * (1.f / (1024.f * RSS_SCALE)) + EPSF)
#define RSS_ADD(p, v) atomicAdd((p), (rss_t)((v) * RSS_SCALE + 0.5f))

__device__ __forceinline__ void ph_win(const bf16_t* xbp, const rss_t* rs, const bf16_t* Wt, bf16_t* ugp, char* smem) {
  LANE_IDS
  RowPlain ar{xbp, 1024};
  for (int t = blockIdx.x; t < 128 * 4; t += gridDim.x) {
    int mt, nt; tile_map(t, 128, 4, mt, nt); const int m0 = mt * 256, n0 = nt * 256;
    f32x4 acc[8][4]; zero_acc(acc);
    kloop(acc, ar, Wt, 1024, m0, n0, 16, smem);
    EPI_IDS
#pragma unroll
    for (int m = 0; m < 8; ++m) {
      const int tok = m0 + ROWL(m);
      const float rstd = RSTD(rs, tok);
#pragma unroll
      for (int p = 0; p < 2; ++p) {
        const int c0 = n0 + COLP(p), g = c0 >> 4;
        const f32x4 v0 = acc[m][2 * p] * rstd, v1 = acc[m][2 * p + 1] * rstd;
        u32x4 o; o.x = pack2(v0[0], v0[1]); o.y = pack2(v0[2], v0[3]); o.z = pack2(v1[0], v1[1]); o.w = pack2(v1[2], v1[3]);
        *(u32x4*)(ugp + ((size_t)(g * 2048 + (tok >> 4)) * 256 + (tok & 15) * 16 + (c0 & 15))) = o;
      }
    }
  }
}

__device__ __forceinline__ void ph_sstate(const bf16_t* ugp, const bf16_t* PTp, float* S, char* smem) {
  LANE_IDS
  for (int t = blockIdx.x; t < 64 * 8; t += gridDim.x) {
    const int g = t >> 3, mt = t & 7, m0 = mt * 256;
    RowPlain ar{ugp + (size_t)g * 2048 * 256, 256};
    f32x4 acc[8][4]; zero_acc(acc);
    kloop(acc, ar, PTp + (size_t)g * 128 * 256, 256, m0, 0, 4, smem);
    EPI_IDS
    if (wc < 2) {
#pragma unroll
      for (int m = 0; m < 8; ++m) {
        const int row = m0 + ROWL(m);
#pragma unroll
        for (int n = 0; n < 4; ++n) *(f32x4*)(S + ((size_t)row * 64 + g) * 128 + COLL(n)) = acc[m][n];
      }
    }
  }
}

__device__ __forceinline__ void ph_scan(const float* S, const float* a16p, bf16_t* Xcp) {
  int tid_ = threadIdx.x; asm volatile("" : "+v"(tid_));
  for (int idx = blockIdx.x * NTHR + tid_; idx < 16 * 64 * 64; idx += gridDim.x * NTHR) {
    const int p = idx & 63, g = (idx >> 6) & 63, b = idx >> 12;
    const float ar = a16p[(g * 64 + p) * 2], ai = a16p[(g * 64 + p) * 2 + 1];
    float xr = 0.f, xi = 0.f;
#pragma unroll 8
    for (int c = 0; c < 128; ++c) {
      const size_t off = ((size_t)(b * 128 + c) * 64 + g) * 128;
      Xcp[off + p] = f2bf(xr); Xcp[off + 64 + p] = f2bf(xi);
      const float sr = S[off + p], si = S[off + 64 + p];
      const float nr = ar * xr - ai * xi + sr, ni = ar * xi + ai * xr + si;
      xr = nr; xi = ni;
    }
  }
}

__device__ __forceinline__ void ph_ssmy(const bf16_t* ugp, const bf16_t* Xcp, const bf16_t* YTp, const float* dskip, bf16_t* gyp, char* smem) {
  LANE_IDS
  for (int t = blockIdx.x; t < 64 * 8; t += gridDim.x) {
    const int g = t >> 3, mt = t & 7, m0 = mt * 256;
    const bf16_t* ugg = ugp + (size_t)g * 2048 * 256;
    RowSsmY ar{ugg, Xcp + (size_t)g * 128};
    f32x4 acc[8][4]; zero_acc(acc);
    kloop(acc, ar, YTp + (size_t)g * 256 * 384, 384, m0, 0, 6, smem);
    EPI_IDS
    const f32x4 dv = *(const f32x4*)(dskip + g * 16 + lq * 4);
#pragma unroll
    for (int m = 0; m < 8; ++m) {
      asm volatile("" ::: "memory");
      const int row = m0 + ROWL(m);
#pragma unroll
      for (int n = 0; n < 4; ++n) {
        const int tt = wc * 4 + n;
        const u32x2 uu = *(const u32x2*)(ugg + (size_t)row * 256 + tt * 16 + lq * 4);
        f32x4 y = acc[m][n];
        y[0] += dv[0] * bflo(uu.x); y[1] += dv[1] * bfhi(uu.x); y[2] += dv[2] * bflo(uu.y); y[3] += dv[3] * bfhi(uu.y);
        u32x2 o; o.x = pack2(gelu_t(y[0]), gelu_t(y[1])); o.y = pack2(gelu_t(y[2]), gelu_t(y[3]));
        *(u32x2*)(gyp + (size_t)(row * 16 + tt) * 1024 + g * 16 + lq * 4) = o;
      }
    }
  }
}

__device__ __forceinline__ void ph_ssm_fused(const bf16_t* ugp, const bf16_t* PTp, const bf16_t* YTp, const float* a16p, bf16_t* Xcp,
                                             const float* dskip, bf16_t* gyp, char* smem) {
  LANE_IDS
  float* Sl = (float*)smem;
  for (int t = blockIdx.x; t < 64 * 8; t += gridDim.x) {
    const int g = t >> 3, mt = t & 7, m0 = mt * 256;
    const bf16_t* ugg = ugp + (size_t)g * 2048 * 256;
    {
      RowPlain ar{ugg, 256};
      f32x4 acc[8][4]; zero_acc(acc);
      kloop(acc, ar, PTp + (size_t)g * 128 * 256, 256, m0, 0, 4, smem);
      EPI_IDS
      if (wc < 2) {
#pragma unroll
        for (int m = 0; m < 8; ++m)
#pragma unroll
          for (int n = 0; n < 4; ++n) *(f32x4*)(Sl + ROWL(m) * 128 + COLL(n)) = acc[m][n];
      }
    }
    __syncthreads();
    if (tid < 128) {
      const int bb = tid >> 6, p = tid & 63;
      const float ar_ = a16p[(g * 64 + p) * 2], ai_ = a16p[(g * 64 + p) * 2 + 1];
      float xr = 0.f, xi = 0.f;
      bf16_t* xo = Xcp + ((size_t)(m0 + bb * 128) * 64 + g) * 128;
      const float* sl = Sl + (bb * 128) * 128;
#pragma unroll 8
      for (int c = 0; c < 128; ++c) {
        xo[(size_t)c * 8192 + p] = f2bf(xr); xo[(size_t)c * 8192 + 64 + p] = f2bf(xi);
        const float sr = sl[c * 128 + p], si = sl[c * 128 + 64 + p];
        const float nr = ar_ * xr - ai_ * xi + sr, ni = ar_ * xi + ai_ * xr + si;
        xr = nr; xi = ni;
      }
    }
    __builtin_amdgcn_fence(__ATOMIC_RELEASE, "workgroup");
    asm volatile("s_waitcnt vmcnt(0)" ::: "memory");
    __syncthreads();
    {
      RowSsmY ar{ugg, Xcp + (size_t)g * 128};
      f32x4 acc[8][4]; zero_acc(acc);
      kloop(acc, ar, YTp + (size_t)g * 256 * 384, 384, m0, 0, 6, smem);
      EPI_IDS
      const f32x4 dv = *(const f32x4*)(dskip + g * 16 + lq * 4);
#pragma unroll
      for (int m = 0; m < 8; ++m) {
        asm volatile("" ::: "memory");
        const int row = m0 + ROWL(m);
#pragma unroll
        for (int n = 0; n < 4; ++n) {
          const int tt = wc * 4 + n;
          const u32x2 uu = *(const u32x2*)(ugg + (size_t)row * 256 + tt * 16 + lq * 4);
          f32x4 y = acc[m][n];
          y[0] += dv[0] * bflo(uu.x); y[1] += dv[1] * bfhi(uu.x); y[2] += dv[2] * bflo(uu.y); y[3] += dv[3] * bfhi(uu.y);
          u32x2 o; o.x = pack2(gelu_t(y[0]), gelu_t(y[1])); o.y = pack2(gelu_t(y[2]), gelu_t(y[3]));
          *(u32x2*)(gyp + (size_t)(row * 16 + tt) * 1024 + g * 16 + lq * 4) = o;
        }
      }
    }
  }
}

__device__ __forceinline__ void ph_wglu(const bf16_t* gyp, const bf16_t* Wt, bf16_t* xbp, rss_t* rso, char* smem) {
  LANE_IDS
  RowPlain ar{gyp, 1024};
  for (int t = blockIdx.x; t < 128 * 8; t += gridDim.x) {
    int mt, nt; tile_map(t, 128, 8, mt, nt); const int m0 = mt * 256, n0 = nt * 256;
    f32x4 acc[8][4]; zero_acc(acc);
    kloop(acc, ar, Wt, 1024, m0, n0, 16, smem);
    EPI_IDS
    const int oc = ((n0 + wc * 64) >> 1) + lq * 8;
    u32x4 xq[2];
#pragma unroll
    for (int m = 0; m < 2; ++m) xq[m] = *(const u32x4*)(xbp + (size_t)(m0 + ROWL(m)) * 1024 + oc);
#pragma unroll
    for (int m = 0; m < 8; ++m) {
      const int row = m0 + ROWL(m);
      const size_t rowoff = (size_t)row * 1024;
      asm volatile("" ::: "memory");
      const u32x4 xr = xq[m & 1];
      f32x4 xa = (f32x4){bflo(xr.x), bfhi(xr.x), bflo(xr.y), bfhi(xr.y)}, xc = (f32x4){bflo(xr.z), bfhi(xr.z), bflo(xr.w), bfhi(xr.w)};
#pragma unroll
      for (int r = 0; r < 4; ++r) { xa[r] += acc[m][0][r] * sigm(acc[m][1][r]); xc[r] += acc[m][2][r] * sigm(acc[m][3][r]); }
      u32x4 o; o.x = pack2(xa[0], xa[1]); o.y = pack2(xa[2], xa[3]); o.z = pack2(xc[0], xc[1]); o.w = pack2(xc[2], xc[3]);
      *(u32x4*)(xbp + rowoff + oc) = o;
      float ss = sq4(xa) + sq4(xc);
      if (m + 2 < 8) xq[m & 1] = *(const u32x4*)(xbp + (size_t)(m0 + ROWL(m + 2)) * 1024 + oc);
      ss += __shfl_xor(ss, 16); ss += __shfl_xor(ss, 32);
      if (lq == 0) RSS_ADD(rso + row, ss);
    }
  }
}

__device__ __forceinline__ void ph_resid(const bf16_t* A, int K, const bf16_t* Bt, bf16_t* xbp, rss_t* rso, char* smem) {
  LANE_IDS
  RowPlain ar{A, K};
  for (int t = blockIdx.x; t < 128 * 4; t += gridDim.x) {
    int mt, nt; tile_map(t, 128, 4, mt, nt); const int m0 = mt * 256, n0 = nt * 256;
    f32x4 acc[8][4]; zero_acc(acc);
    kloop(acc, ar, Bt, K, m0, n0, K >> 6, smem);
    EPI_IDS
    u32x4 xq[2][2];
#pragma unroll
    for (int m = 0; m < 2; ++m)
#pragma unroll
      for (int p = 0; p < 2; ++p) xq[m][p] = *(const u32x4*)(xbp + (size_t)(m0 + ROWL(m)) * 1024 + n0 + COLP(p));
#pragma unroll
    for (int m = 0; m < 8; ++m) {
      const int row = m0 + ROWL(m);
      const size_t rowoff = (size_t)row * 1024;
      float ss = 0.f;
      asm volatile("" ::: "memory");
#pragma unroll
      for (int p = 0; p < 2; ++p) {
        const int oc = n0 + COLP(p);
        const u32x4 xr = xq[m & 1][p];
        f32x4 xa = acc[m][2 * p], xc = acc[m][2 * p + 1];
        xa[0] += bflo(xr.x); xa[1] += bfhi(xr.x); xa[2] += bflo(xr.y); xa[3] += bfhi(xr.y);
        xc[0] += bflo(xr.z); xc[1] += bfhi(xr.z); xc[2] += bflo(xr.w); xc[3] += bfhi(xr.w);
        u32x4 o; o.x = pack2(xa[0], xa[1]); o.y = pack2(xa[2], xa[3]); o.z = pack2(xc[0], xc[1]); o.w = pack2(xc[2], xc[3]);
        *(u32x4*)(xbp + rowoff + oc) = o;
        ss += sq4(xa) + sq4(xc);
      }
      if (m + 2 < 8) {
#pragma unroll
        for (int p = 0; p < 2; ++p) xq[m & 1][p] = *(const u32x4*)(xbp + (size_t)(m0 + ROWL(m + 2)) * 1024 + n0 + COLP(p));
      }
      ss += __shfl_xor(ss, 16); ss += __shfl_xor(ss, 32);
      if (lq == 0) RSS_ADD(rso + row, ss);
    }
  }
}

__device__ __forceinline__ void ph_halo_proj(const bf16_t* xbp, const rss_t* rs, const bf16_t* WupTp, float* halop, const bf16_t* pbf, const bf16_t* WpjTp, bf16_t* pj, char* smem) {
  LANE_IDS
  for (int t = blockIdx.x; t < 44; t += gridDim.x) {
    f32x4 acc[8][4]; zero_acc(acc);
    const int nt = t >> 1, kh = t & 1, m0 = 0, n0 = nt * 256;
    RowHalo ar{xbp, kh * 8};
    kloop(acc, ar, WupTp + kh * 512, 1024, m0, n0, 8, smem);
    EPI_IDS
#pragma unroll
    for (int m = 0; m < 8; ++m) {
      const int r = m0 + ROWL(m);
      int tok = 256 * (r >> 1) - 2 + (r & 1); tok = tok < 0 ? 0 : tok;
      const float rstd = RSTD(rs, tok);
#pragma unroll
      for (int n = 0; n < 4; ++n) *(f32x4*)(halop + (size_t)kh * 256 * 5632 + (size_t)r * 5632 + n0 + COLP(n >> 1) + (n & 1) * 4) = acc[m][n] * rstd;
    }
  }
}
__device__ __forceinline__ void ph_proj(const bf16_t* pbf, const bf16_t* WpjTp, bf16_t* pj, char* smem) {
  LANE_IDS
  for (int t = gridDim.x - 1 - blockIdx.x; t < 512; t += gridDim.x) {
    f32x4 acc[8][4]; zero_acc(acc);
    int mt, nt; tile_map(t, 128, 4, mt, nt); const int m0 = mt * 256, n0 = nt * 256;
    RowPlain ar{pbf, 256};
    kloop(acc, ar, WpjTp, 256, m0, n0, 4, smem);
    EPI_IDS
#pragma unroll
    for (int m = 0; m < 8; ++m) {
      const size_t rowoff = (size_t)(m0 + ROWL(m)) * 1024;
#pragma unroll
      for (int p = 0; p < 2; ++p) {
        const f32x4 a0 = acc[m][2 * p], a1 = acc[m][2 * p + 1];
        u32x4 o; o.x = pack2(a0[0], a0[1]); o.y = pack2(a0[2], a0[3]); o.z = pack2(a1[0], a1[1]); o.w = pack2(a1[2], a1[3]);
        *(u32x4*)(pj + rowoff + n0 + COLP(p)) = o;
      }
    }
  }
}

__device__ __forceinline__ void ph_up(const bf16_t* xbp, const rss_t* rs, const bf16_t* WupTp, const float* halop, const float* convw, const float* convb, bf16_t* actp, char* smem) {
  LANE_IDS
  RowPlain ar{xbp, 1024};
  bf16_t* st = (bf16_t*)(smem + 1024);
  for (int t = blockIdx.x; t < 128 * 22; t += gridDim.x) {
    int mt, nt; tile_map(t, 128, 22, mt, nt); const int m0 = mt * 256, n0 = nt * 256;
    f32x4 acc[8][4]; zero_acc(acc);
    kloop(acc, ar, WupTp, 1024, m0, n0, 16, smem);
    EPI_IDS
#pragma unroll
    for (int m = 0; m < 8; ++m) {
      const float rstd = RSTD(rs, m0 + ROWL(m));
#pragma unroll
      for (int p = 0; p < 2; ++p) {
        const f32x4 v0 = acc[m][2 * p] * rstd, v1 = acc[m][2 * p + 1] * rstd;
        u32x4 o; o.x = pack2(v0[0], v0[1]); o.y = pack2(v0[2], v0[3]); o.z = pack2(v1[0], v1[1]); o.w = pack2(v1[2], v1[3]);
        *(u32x4*)(st + (2 + ROWL(m)) * 256 + COLP(p)) = o;
      }
    }
    {
      const int j = tid >> 8, col = tid & 255;
      float hv = 0.f;
      if ((m0 & 2047) != 0) hv = halop[(size_t)(2 * mt + j) * 5632 + n0 + col] + halop[(size_t)256 * 5632 + (size_t)(2 * mt + j) * 5632 + n0 + col];
      st[j * 256 + col] = f2bf(hv);
    }
    __syncthreads();
    {
      const int cp = tid & 31, rg = tid >> 5;
      const int hc = nt * 128 + 4 * cp;
      float wg[3][4], wv[3][4], bg[4], bv[4];
#pragma unroll
      for (int j = 0; j < 3; ++j) {
        const f32x4 a = *(const f32x4*)(convw + j * 5632 + hc), c = *(const f32x4*)(convw + j * 5632 + 2816 + hc);
#pragma unroll
        for (int e = 0; e < 4; ++e) { wg[j][e] = a[e]; wv[j][e] = c[e]; }
      }
      {
        const f32x4 a = *(const f32x4*)(convb + hc), c = *(const f32x4*)(convb + 2816 + hc);
#pragma unroll
        for (int e = 0; e < 4; ++e) { bg[e] = a[e]; bv[e] = c[e]; }
      }
      const int r0 = rg * 16;
      u32x2 g2 = *(const u32x2*)(st + (r0) * 256 + 4 * cp), v2 = *(const u32x2*)(st + (r0) * 256 + 128 + 4 * cp);
      u32x2 g1 = *(const u32x2*)(st + (r0 + 1) * 256 + 4 * cp), v1 = *(const u32x2*)(st + (r0 + 1) * 256 + 128 + 4 * cp);
#pragma unroll 4
      for (int r = 0; r < 16; ++r) {
        const u32x2 g0 = *(const u32x2*)(st + (r0 + r + 2) * 256 + 4 * cp), v0 = *(const u32x2*)(st + (r0 + r + 2) * 256 + 128 + 4 * cp);
        float o4[4];
#pragma unroll
        for (int e = 0; e < 4; ++e) {
          const uint32_t wg2 = (e < 2) ? g2.x : g2.y, wg1 = (e < 2) ? g1.x : g1.y, wg0 = (e < 2) ? g0.x : g0.y;
          const uint32_t wv2 = (e < 2) ? v2.x : v2.y, wv1 = (e < 2) ? v1.x : v1.y, wv0 = (e < 2) ? v0.x : v0.y;
          const float a2 = (e & 1) ? bfhi(wg2) : bflo(wg2), a1 = (e & 1) ? bfhi(wg1) : bflo(wg1), a0 = (e & 1) ? bfhi(wg0) : bflo(wg0);
          const float c2 = (e & 1) ? bfhi(wv2) : bflo(wv2), c1 = (e & 1) ? bfhi(wv1) : bflo(wv1), c0 = (e & 1) ? bfhi(wv0) : bflo(wv0);
          const float cg = bg[e] + wg[0][e] * a2 + wg[1][e] * a1 + wg[2][e] * a0;
          const float cv = bv[e] + wv[0][e] * c2 + wv[1][e] * c1 + wv[2][e] * c0;
          o4[e] = gelu_t(cg) * cv;
        }
        u32x2 o; o.x = pack2(o4[0], o4[1]); o.y = pack2(o4[2], o4[3]);
        *(u32x2*)(actp + (size_t)(m0 + r0 + r) * 2816 + hc) = o;
        g2 = g1; g1 = g0; v2 = v1; v1 = v0;
      }
    }
  }
}

__device__ __forceinline__ void ph_ple(const bf16_t* xbp, const rss_t* rs, const bf16_t* WgtTp, float* xout, bf16_t* xnx, rss_t* rso, bool last, char* smem) {
  LANE_IDS
  RowPlain ar{xbp, 1024};
  for (int t = blockIdx.x; t < 128 * 4; t += gridDim.x) {
    int mt, nt; tile_map(t, 128, 4, mt, nt); const int m0 = mt * 256, n0 = nt * 256;
    f32x4 acc[8][4]; zero_acc(acc);
    kloop(acc, ar, WgtTp, 1024, m0, n0, 16, smem);
    EPI_IDS
    u32x4 xq[2][2], pq[2][2]; float rq[2];
#pragma unroll
    for (int m = 0; m < 2; ++m) {
      rq[m] = RSTD(rs, m0 + ROWL(m));
#pragma unroll
      for (int p = 0; p < 2; ++p) {
        xq[m][p] = *(const u32x4*)(xbp + (size_t)(m0 + ROWL(m)) * 1024 + n0 + COLP(p));
        pq[m][p] = *(const u32x4*)(xnx + (size_t)(m0 + ROWL(m)) * 1024 + n0 + COLP(p));
      }
    }
#pragma unroll
    for (int m = 0; m < 8; ++m) {
      const int row = m0 + ROWL(m);
      const size_t rowoff = (size_t)row * 1024;
      float ss = 0.f;
      asm volatile("" ::: "memory");
      const float rstd = rq[m & 1];
#pragma unroll
      for (int p = 0; p < 2; ++p) {
        const int oc = n0 + COLP(p);
        const u32x4 xr = xq[m & 1][p];
        const u32x4 pp = pq[m & 1][p];
        const f32x4 g0 = acc[m][2 * p], g1 = acc[m][2 * p + 1];
        f32x4 xa, xc;
        xa[0] = bflo(xr.x) + sigm(g0[0] * rstd) * bflo(pp.x);
        xa[1] = bfhi(xr.x) + sigm(g0[1] * rstd) * bfhi(pp.x);
        xa[2] = bflo(xr.y) + sigm(g0[2] * rstd) * bflo(pp.y);
        xa[3] = bfhi(xr.y) + sigm(g0[3] * rstd) * bfhi(pp.y);
        xc[0] = bflo(xr.z) + sigm(g1[0] * rstd) * bflo(pp.z);
        xc[1] = bfhi(xr.z) + sigm(g1[1] * rstd) * bfhi(pp.z);
        xc[2] = bflo(xr.w) + sigm(g1[2] * rstd) * bflo(pp.w);
        xc[3] = bfhi(xr.w) + sigm(g1[3] * rstd) * bfhi(pp.w);
        if (last) { *(f32x4*)(xout + rowoff + oc) = xa; *(f32x4*)(xout + rowoff + oc + 4) = xc; }
        else {
          u32x4 o; o.x = pack2(xa[0], xa[1]); o.y = pack2(xa[2], xa[3]); o.z = pack2(xc[0], xc[1]); o.w = pack2(xc[2], xc[3]);
          *(u32x4*)(xnx + rowoff + oc) = o;
          ss += sq4(xa) + sq4(xc);
        }
      }
      if (m + 2 < 8) {
        rq[m & 1] = RSTD(rs, m0 + ROWL(m + 2));
#pragma unroll
        for (int p = 0; p < 2; ++p) {
          xq[m & 1][p] = *(const u32x4*)(xbp + (size_t)(m0 + ROWL(m + 2)) * 1024 + n0 + COLP(p));
          pq[m & 1][p] = *(const u32x4*)(xnx + (size_t)(m0 + ROWL(m + 2)) * 1024 + n0 + COLP(p));
        }
      }
      if (!last) {
        ss += __shfl_xor(ss, 16); ss += __shfl_xor(ss, 32);
        if (lq == 0) RSS_ADD(rso + row, ss);
      }
    }
  }
}

__device__ __forceinline__ void ph_kvq(const bf16_t* xbp, const rss_t* rs, const bf16_t* Wt, int NT, int coloff, const float* knorm, const float* qnorm,
                       bf16_t* Kbp, bf16_t* Vtp, bf16_t* Qbp, char* smem) {
  LANE_IDS
  RowPlain ar{xbp, 1024};
  const float qscale = 0.125f * 1.4426950408889634f;
  for (int t = blockIdx.x; t < 128 * NT; t += gridDim.x) {
    int mt, nt; tile_map(t, 128, NT, mt, nt); const int m0 = mt * 256, n0 = nt * 256;
    f32x4 acc[8][4]; zero_acc(acc);
    kloop(acc, ar, Wt, 1024, m0, n0, 16, smem);
    EPI_IDS
    const int cw = coloff + n0 + wc * 64;
#pragma unroll
    for (int m = 0; m < 8; ++m) {
      const int tok = m0 + ROWL(m);
      const float rstd = RSTD(rs, tok);
      f32x4 v[4];
      float ss = 0.f;
#pragma unroll
      for (int n = 0; n < 4; ++n) { v[n] = acc[m][n] * rstd; ss += sq4(v[n]); }
      if (cw >= 1024 && cw < 2048) {
        const int b = tok >> 11, tt = tok & 2047;
#pragma unroll
        for (int n = 0; n < 4; ++n)
#pragma unroll
          for (int r = 0; r < 4; ++r) {
            const int j = cw - 1024 + (n >> 1) * 32 + lq * 8 + (n & 1) * 4 + r;
            Vtp[((size_t)(b * 1024 + j)) * 2048 + tt] = f2bf(v[n][r]);
          }
      } else {
        ss += __shfl_xor(ss, 16); ss += __shfl_xor(ss, 32);
        const bool isq = cw >= 2048;
        const float hn = rsqrtf(ss * (1.f / 64.f) + EPSF) * (isq ? qscale : 1.f);
        const float* gn = isq ? qnorm : knorm;
        bf16_t* dst = isq ? (Qbp + (size_t)tok * 1024 + (cw - 2048)) : (Kbp + (size_t)tok * 1024 + cw);
#pragma unroll
        for (int p = 0; p < 2; ++p) {
          const int d0 = p * 32 + lq * 8;
          const f32x4 g0 = *(const f32x4*)(gn + d0), g1 = *(const f32x4*)(gn + d0 + 4);
          const f32x4 a0 = v[2 * p] * hn * g0, a1 = v[2 * p + 1] * hn * g1;
          u32x4 o; o.x = pack2(a0[0], a0[1]); o.y = pack2(a0[2], a0[3]); o.z = pack2(a1[0], a1[1]); o.w = pack2(a1[2], a1[3]);
          *(u32x4*)(dst + d0) = o;
        }
      }
    }
  }
}

#define ATT_COMPUTE(KT_, KST_) do { \
_Pragma("unroll 1") \
      for (int hf = 0; hf < 2; ++hf) { \
        const int key0 = (KT_) * 64 + hf * 32; \
        if (key0 > q0 + wid * 16 + 15) break;     \
        const char* Ks = KST_ + hf * 32 * 272; \
        const char* Vs = KST_ + 17408 + hf * 64; \
        const bool far = (q0 + wid * 16 - (key0 + 31)) >= 128;       \
        const bool diag = key0 + 31 > q0 + wid * 16;                 \
        float bias[2][4]; \
        if (!far) { \
_Pragma("unroll") \
          for (int nf = 0; nf < 2; ++nf) \
_Pragma("unroll") \
            for (int r = 0; r < 4; ++r) { \
              const int dist = qpos - (key0 + lq * 8 + nf * 4 + r); \
              const int idx = dist < 0 ? 0 : (dist > 128 ? 128 : dist); \
              bias[nf][r] = (diag && dist < 0) ? -1e30f : tab[idx]; \
            } \
        } else { \
_Pragma("unroll") \
          for (int nf = 0; nf < 2; ++nf) \
_Pragma("unroll") \
            for (int r = 0; r < 4; ++r) bias[nf][r] = bfar; \
        } \
          \
        __builtin_amdgcn_sched_barrier(0);     \
        bf16x8 kfa[2][2], kfb[2][2]; \
_Pragma("unroll") \
        for (int nf = 0; nf < 2; ++nf) \
_Pragma("unroll") \
          for (int ks = 0; ks < 2; ++ks) \
            kfa[nf][ks] = *(const bf16x8*)(Ks + (8 * (lr >> 2) + 4 * nf + (lr & 3)) * 272 + (ks * 32 + lq * 8) * 2);     \
        __builtin_amdgcn_sched_barrier(0);     \
        f32x4 sa[2], sb[2]; \
_Pragma("unroll") \
        for (int nf = 0; nf < 2; ++nf) { \
          f32x4 a = (f32x4){0.f, 0.f, 0.f, 0.f}; \
_Pragma("unroll") \
          for (int ks = 0; ks < 2; ++ks) a = __builtin_amdgcn_mfma_f32_16x16x32_bf16(kfa[nf][ks], qf[0][ks], a, 0, 0, 0); \
          sa[nf] = a; \
_Pragma("unroll") \
          for (int ks = 0; ks < 2; ++ks) \
            kfb[nf][ks] = *(const bf16x8*)(Ks + (8 * (lr >> 2) + 4 * nf + (lr & 3)) * 272 + (64 + ks * 32 + lq * 8) * 2); \
        } \
        __builtin_amdgcn_sched_barrier(0);     \
        bf16x8 vfa[4], vfb[4]; \
_Pragma("unroll") \
        for (int nf = 0; nf < 2; ++nf) { \
          f32x4 a = (f32x4){0.f, 0.f, 0.f, 0.f}; \
_Pragma("unroll") \
          for (int ks = 0; ks < 2; ++ks) a = __builtin_amdgcn_mfma_f32_16x16x32_bf16(kfb[nf][ks], qf[1][ks], a, 0, 0, 0); \
          sb[nf] = a; \
        } \
_Pragma("unroll") \
        for (int ef = 0; ef < 4; ++ef) vfa[ef] = *(const bf16x8*)(Vs + (ef * 16 + lr) * 144 + lq * 16); \
        bf16x8 pk[2]; \
        { float ps0 = 0.f, ps1 = 0.f; \
_Pragma("unroll") \
          for (int nf = 0; nf < 2; ++nf) \
_Pragma("unroll") \
            for (int r = 0; r < 4; ++r) { \
              const float p0 = __builtin_amdgcn_exp2f(sa[nf][r] + (bias[nf][r] - mb[0]));     \
              const float p1 = __builtin_amdgcn_exp2f(sb[nf][r] + (bias[nf][r] - mb[1])); \
              sa[nf][r] = p0; sb[nf][r] = p1; ps0 += p0; ps1 += p1; \
            } \
          lrun[0] += ps0; lrun[1] += ps1; \
          union { uint32_t u[4]; bf16x8 v; } cvt; \
          cvt.u[0] = pack2(sa[0][0], sa[0][1]); cvt.u[1] = pack2(sa[0][2], sa[0][3]); cvt.u[2] = pack2(sa[1][0], sa[1][1]); cvt.u[3] = pack2(sa[1][2], sa[1][3]); \
          pk[0] = cvt.v; \
          cvt.u[0] = pack2(sb[0][0], sb[0][1]); cvt.u[1] = pack2(sb[0][2], sb[0][3]); cvt.u[2] = pack2(sb[1][0], sb[1][1]); cvt.u[3] = pack2(sb[1][2], sb[1][3]); \
          pk[1] = cvt.v; } \
        __builtin_amdgcn_sched_barrier(0);     \
_Pragma("unroll") \
        for (int ef = 0; ef < 4; ++ef) { \
          oacc[0][ef] = __builtin_amdgcn_mfma_f32_16x16x32_bf16(vfa[ef], pk[0], oacc[0][ef], 0, 0, 0); \
          oacc[1][ef] = __builtin_amdgcn_mfma_f32_16x16x32_bf16(vfa[ef], pk[1], oacc[1][ef], 0, 0, 0); \
          vfb[ef] = *(const bf16x8*)(Vs + ((ef + 4) * 16 + lr) * 144 + lq * 16); \
        } \
        __builtin_amdgcn_sched_barrier(0);     \
_Pragma("unroll") \
        for (int ef = 0; ef < 4; ++ef) { \
          oacc[0][ef + 4] = __builtin_amdgcn_mfma_f32_16x16x32_bf16(vfb[ef], pk[0], oacc[0][ef + 4], 0, 0, 0); \
          oacc[1][ef + 4] = __builtin_amdgcn_mfma_f32_16x16x32_bf16(vfb[ef], pk[1], oacc[1][ef + 4], 0, 0, 0); \
        } \
        __builtin_amdgcn_sched_barrier(0); \
      } \
      } while (0)
__device__ __forceinline__ void ph_attn(const bf16_t* Qin, bf16_t* Oout, const bf16_t* Kbp, const bf16_t* Vtp, const float* tabgp, const float* knorm, const float* lq1, const float* lk1,
                        const float* lq2, const float* lk2, const float* subln, int Lidx, char* smc) {
  LANE_IDS
  const int lq = lane >> 4, lr = lane & 15;
  float* tab = (float*)smc;
  char* stg = smc + 1024;
  float s1 = 0.f, s2 = 0.f, kmax = 0.f;
  for (int d = 0; d < 64; ++d) { s1 += lq1[d] * lk1[d]; s2 += lq2[d] * lk2[d]; kmax = fmaxf(kmax, fabsf(knorm[d])); }
  asm volatile("" : "+s"(Lidx));
  const float lam_init = (Lidx == 2) ? 0.47071302f : 0.55605820f;
  const float lam = expf(s1) - expf(s2) + lam_init;
  const float osc = 1.f - lam_init;
  const float kb = 8.08f * kmax;
  for (int w = blockIdx.x; w < 2048; w += gridDim.x) {
    const int i8 = w & 255, k8 = w >> 8, xcd = i8 & 7, slot = i8 >> 3, jq = slot & 15;
    const int bh = xcd + 8 * (2 * k8 + (slot >> 4));
    const int qb = (k8 & 1) ? (15 - jq) : jq;
    const int b = bh >> 3, h = bh & 7;
    const int q0 = qb * 128, tb = b * 2048;
    const int qpos = q0 + wid * 16 + lr;
    const bf16_t* kbase = Kbp + (size_t)tb * 1024 + h * 128;
    const bf16_t* vbase = Vtp + (size_t)(b * 8 + h) * 128 * 2048;
    const int nkt = 2 * (qb + 1);
    u32x4 kr0[2], vr0[2], kr1[2], vr1[2];
    if (tid < 130) tab[tid] = tabgp[h * 132 + tid];
    bf16x8 qf[2][2];
    float mb[2];
#pragma unroll
    for (int c = 0; c < 2; ++c) {
      float ss = 0.f;
#pragma unroll
      for (int ks = 0; ks < 2; ++ks) {
        const u32x4 qq = *(const u32x4*)(Qin + (size_t)(tb + qpos) * 1024 + h * 128 + c * 64 + ks * 32 + lq * 8);
        union { u32x4 u; bf16x8 v; } cv; cv.u = qq; qf[c][ks] = cv.v;
        ss += bflo(qq.x) * bflo(qq.x) + bfhi(qq.x) * bfhi(qq.x) + bflo(qq.y) * bflo(qq.y) + bfhi(qq.y) * bfhi(qq.y)
            + bflo(qq.z) * bflo(qq.z) + bfhi(qq.z) * bfhi(qq.z) + bflo(qq.w) * bflo(qq.w) + bfhi(qq.w) * bfhi(qq.w);
      }
      ss += __shfl_xor(ss, 16); ss += __shfl_xor(ss, 32);
      mb[c] = sqrtf(ss) * kb;
    }
#define ATT_LOAD(KR, VR, ST) do { _Pragma("unroll") for (int i = 0; i < 2; ++i) { const int v = tid + 512 * i; \
      KR[i] = *(const u32x4*)(kbase + (size_t)((ST) * 64 + (v >> 4)) * 1024 + (v & 15) * 8); \
      VR[i] = *(const u32x4*)(vbase + (size_t)(v >> 3) * 2048 + (ST) * 64 + (v & 7) * 8); } } while (0)
#define ATT_WRITE(KR, VR, BUF) do { char* Kn_ = stg + (BUF) * 35840; _Pragma("unroll") for (int i = 0; i < 2; ++i) { const int v = tid + 512 * i; \
      *(u32x4*)(Kn_ + (v >> 4) * 272 + (v & 15) * 16) = KR[i]; \
      *(u32x4*)(Kn_ + 17408 + (v >> 3) * 144 + (v & 7) * 16) = VR[i]; } } while (0)
    ATT_LOAD(kr0, vr0, 0);
    ATT_LOAD(kr1, vr1, 1);
    ATT_WRITE(kr0, vr0, 0);
    if (nkt > 2) ATT_LOAD(kr0, vr0, 2);
    __syncthreads();
    const float bmax = tab[129];
    const float bfar = tab[128];
    mb[0] += bmax; mb[1] += bmax;
    f32x4 oacc[2][8];
#pragma unroll
    for (int c = 0; c < 2; ++c)
#pragma unroll
      for (int e = 0; e < 8; ++e) oacc[c][e] = (f32x4){0.f, 0.f, 0.f, 0.f};
    float lrun[2] = {0.f, 0.f};
    for (int kt = 0; kt < nkt; kt += 2) {
      ATT_COMPUTE(kt, stg);
      ATT_WRITE(kr1, vr1, 1);
      if (kt + 3 < nkt) ATT_LOAD(kr1, vr1, kt + 3);
      __syncthreads();
      ATT_COMPUTE(kt + 1, (stg + 35840));
      if (kt + 2 < nkt) ATT_WRITE(kr0, vr0, 0);
      if (kt + 4 < nkt) ATT_LOAD(kr0, vr0, kt + 4);
      __syncthreads();
    }
#undef ATT_LOAD
#undef ATT_WRITE
    float l0 = lrun[0], l1 = lrun[1];
    l0 += __shfl_xor(l0, 16); l0 += __shfl_xor(l0, 32);
    l1 += __shfl_xor(l1, 16); l1 += __shfl_xor(l1, 32);
    const float i0 = 1.f / l0, i1 = lam / l1;
    float ss = 0.f;
#pragma unroll
    for (int e = 0; e < 8; ++e) {
      oacc[0][e] = oacc[0][e] * i0 - oacc[1][e] * i1;
      ss += sq4(oacc[0][e]);
    }
    ss += __shfl_xor(ss, 16); ss += __shfl_xor(ss, 32);
    const float rn = rsqrtf(ss * (1.f / 128.f) + EPSF) * osc;
#pragma unroll
    for (int e = 0; e < 8; ++e) {
      const f32x4 gv = *(const f32x4*)(subln + e * 16 + lq * 4);
      const f32x4 o = oacc[0][e] * rn * gv;
      u32x2 wv; wv.x = pack2(o[0], o[1]); wv.y = pack2(o[2], o[3]);
      *(u32x2*)(Oout + (size_t)(tb + qpos) * 1024 + h * 128 + e * 16 + lq * 4) = wv;
    }
  }
}

#define XB_TMO      128
#define XB_XCNT(j)  (256  + 64 * (j))
#define XB_XSUB(j)  (1280 + 64 * (j))
#define XB_XGEN(j)  (2304 + 64 * (j))
#define XB_TOP      3328
#define XB_TOPGEN   3392
#define XCD_BAR_WORDS 3456
#define XB_SPIN_CAP (1u << 18)

__device__ __forceinline__ unsigned xb_ld(unsigned* p)              { return __hip_atomic_load(p, __ATOMIC_RELAXED, __HIP_MEMORY_SCOPE_AGENT); }
__device__ __forceinline__ unsigned xb_add(unsigned* p, unsigned v) { return __hip_atomic_fetch_add(p, v, __ATOMIC_RELAXED, __HIP_MEMORY_SCOPE_AGENT); }
__device__ __forceinline__ unsigned xb_xcc_id() { return (unsigned)__builtin_amdgcn_s_getreg((3 << 11) | 20) & 0xFu; }
#define XB_SPIN(cond, bar) do { unsigned _sp = 0; while (cond) { __builtin_amdgcn_s_sleep(1); \
    if ((++_sp & 255u) == 0u) { if (xb_ld(&(bar)[XB_TMO])) break; if (_sp > XB_SPIN_CAP) { atomicAdd(&(bar)[XB_TMO], 1u); break; } } } } while (0)

struct XcdBarrier {
    unsigned* bar; unsigned x;
    volatile LAS unsigned* st;
};

__device__ __forceinline__ XcdBarrier xcd_barrier_post(unsigned* bar, volatile LAS unsigned* st) {
    XcdBarrier b; b.bar = bar; b.x = xb_xcc_id(); b.st = st;
    if (threadIdx.x == 0) (void)xb_add(&bar[XB_XCNT(b.x)], 1u);
    return b;
}
__device__ __forceinline__ void xcd_barrier_complete(unsigned* bar, unsigned x, unsigned& nloc, unsigned& nx) {
    const unsigned G = gridDim.x * gridDim.y * gridDim.z;
    unsigned sum, cnt, mine, sp = 0u;
    for (;;) {
        sum = 0u; cnt = 0u; mine = 0u;
#pragma unroll
        for (unsigned j = 0; j < 16; ++j) { const unsigned c = xb_ld(&bar[XB_XCNT(j)]); sum += c; cnt += (c > 0u) ? 1u : 0u; mine = (j == x) ? c : mine; }
        if (sum == G) break;
        __builtin_amdgcn_s_sleep(1);
        if ((++sp & 255u) == 0u) { if (xb_ld(&bar[XB_TMO])) break; if (sp > XB_SPIN_CAP) { atomicAdd(&bar[XB_TMO], 1u); break; } }
    }
    nloc = mine > 0u ? mine : 1u; nx = cnt > 0u ? cnt : 1u;
}

__device__ __forceinline__ void xcd_barrier(const XcdBarrier& b) {
    asm volatile("s_waitcnt vmcnt(0)" ::: "memory");
    __syncthreads();
    if (threadIdx.x == 0) {
        unsigned* bar = b.bar;
        __builtin_amdgcn_s_waitcnt(0);
        unsigned nloc = b.st[0], nx = b.st[1];
        if (nloc == 0u) { xcd_barrier_complete(bar, b.x, nloc, nx); b.st[0] = nloc; b.st[1] = nx; }
        const unsigned old = xb_add(&bar[XB_XSUB(b.x)], 1u);
        const unsigned gen = old / nloc;
        if (old + 1u == (gen + 1u) * nloc) {
            __builtin_amdgcn_fence(__ATOMIC_RELEASE, "agent");
            asm volatile("s_waitcnt vmcnt(0)" ::: "memory");
            const unsigned og = xb_add(&bar[XB_TOP], 1u);
            const unsigned tg = og / nx;
            if (og + 1u == (tg + 1u) * nx) xb_add(&bar[XB_TOPGEN], 1u);
            else XB_SPIN(xb_ld(&bar[XB_TOPGEN]) == tg, bar);
            __builtin_amdgcn_fence(__ATOMIC_ACQUIRE, "agent");
            xb_add(&bar[XB_XGEN(b.x)], 1u);
            asm volatile("s_waitcnt vmcnt(0)" ::: "memory");
        } else {
            XB_SPIN(xb_ld(&bar[XB_XGEN(b.x)]) == gen, bar);
            __builtin_amdgcn_fence(__ATOMIC_ACQUIRE, "agent");
            asm volatile("s_waitcnt vmcnt(0)" ::: "memory");
        }
    }
    __syncthreads();
}

#define PHASE_PTRS int z = 0; asm volatile("" : "+s"(z)); char* ws = P.ws + z; const float* const* in = P.in + z; float* x = P.out + z; (void)ws; (void)in; (void)x;
#define WinT ((bf16_t*)(ws + OFF_WIN))
#define WgluT ((bf16_t*)(ws + OFF_WGLU))
#define PT ((bf16_t*)(ws + OFF_PT))
#define YT ((bf16_t*)(ws + OFF_YT))
#define WkvqT ((bf16_t*)(ws + OFF_WKVQ))
#define WoT ((bf16_t*)(ws + OFF_WO))
#define WupT ((bf16_t*)(ws + OFF_WUP))
#define WdnT ((bf16_t*)(ws + OFF_WDN))
#define WgtT ((bf16_t*)(ws + OFF_WGT))
#define WpjT ((bf16_t*)(ws + OFF_WPJ))
#define a16 ((float*)(ws + OFF_SMALL))
#define tabg ((float*)(ws + OFF_SMALL + 65536))
#define SSMC ((float*)(ws + OFF_SMALL + 3584 * 1024))
#define OFF_BAR (OFF_SMALL + 3840 * 1024)
#define ROWSS(v) ((rss_t*)(ws + OFF_SMALL + 131072) + (size_t)(v) * 32768)
#define PBF ((bf16_t*)(ws + OFF_PBF))
#define XBCUR ((bf16_t*)(ws + ((L & 1) ? OFF_XB1 : OFF_XB0)))
#define XBNXT ((bf16_t*)(ws + ((L & 1) ? OFF_XB0 : OFF_XB1)))
#define ug ((bf16_t*)(ws + OFF_UG))
#define S_ ((float*)(ws + OFF_S))
#define Xc ((bf16_t*)(ws + OFF_XC))
#define gy ((bf16_t*)(ws + OFF_GY))
#define Kb ((bf16_t*)(ws + OFF_K))
#define Vt ((bf16_t*)(ws + OFF_VT))
#define QO ((bf16_t*)(ws + OFF_QO))
#define act ((bf16_t*)(ws + OFF_ACT))
#define halo ((float*)(ws + OFF_HALO))
__global__ void __launch_bounds__(NTHR, 2) yoco_mega(Params P) {
  extern __shared__ __attribute__((aligned(1024))) char smraw[];
  float* smf = (float*)smraw;
  volatile LAS unsigned* bst = (volatile LAS unsigned*)(LAS char*)(smraw + 139200);
  if (threadIdx.x == 0) { bst[0] = 0u; bst[1] = 0u; }
  __syncthreads();
  XcdBarrier gbar; gbar.bar = (unsigned*)(P.ws + OFF_BAR); gbar.x = 0; gbar.st = bst;
  if (P.coop) gbar = xcd_barrier_post((unsigned*)(P.ws + OFF_BAR), bst);
  if (P.ph_lo == 0 && blockIdx.x < 64) {
    PHASE_PTRS
    int tid_ = threadIdx.x; asm volatile("" : "+v"(tid_));
    if (tid_ < 128) ssm_consts(in[4], in[5], in[6], SSMC, a16, tid_ >> 6, blockIdx.x, tid_ & 63);
    __threadfence();
  }
  for (int ph = P.ph_lo; ph < P.ph_hi; ++ph) {
    const int L = ph / 10, s = ph % 10;
    const bool isA = L < 2;
    const int j = L - 2;
    const int nrep = ((REPMASK >> s) & 1) ? 2 : 1;
    for (int rep = 0; rep < nrep; ++rep) {
    if ((s == 0 && L == 0) || (s == 9 && L < 3)) {
      PHASE_PTRS
      const int LP = (s == 0) ? 0 : L + 1;
      const bool pA = LP < 2; const int jp = LP - 2;
      if (s == 9) ph_ple(XBCUR, ROWSS(3 * L + 2), WgtT, x, XBNXT, ROWSS(3 * L + 3), false, smraw);
      if (LP == 0) prep_x(in[0], (bf16_t*)(ws + OFF_XB0), ROWSS(0));
      prep_p(in[1] + (size_t)LP * 32768 * 256, PBF);
      if (pA) prep_ssm(SSMC + (size_t)LP * 16384, in[7] + (size_t)LP * 65536, in[8] + (size_t)LP * 65536,
                       in[9] + (size_t)LP * 65536, in[10] + (size_t)LP * 65536, PT, YT, smf);
      else if (jp == 0) prep_bias(in[25], tabg);
#pragma unroll 1
      for (int mi = 0; mi < 7; ++mi) {
        const float* src = nullptr; const float* gain = nullptr; bf16_t* dst = nullptr; int K = 1024, N = 1024, Nsub = 1024, mode = 0;
        if (mi == 0) { src = in[27] + (size_t)LP * 1024 * 5632; N = 5632; Nsub = 5632; dst = WupT; gain = in[26] + LP * 1024; mode = 2; }
        else if (mi == 1) { src = in[30] + (size_t)LP * 2816 * 1024; K = 2816; dst = WdnT; mode = 3; }
        else if (mi == 2) { if (LP != 0) continue; src = in[32]; dst = WgtT; gain = in[31]; mode = 3; }
        else if (mi == 3) { src = in[33] + (size_t)LP * 256 * 1024; K = 256; dst = WpjT; mode = 3; }
        else if (pA) {
          if (mi == 4) { src = in[3] + (size_t)LP * 1024 * 1024; dst = WinT; gain = in[2] + LP * 1024; mode = 3; }
          else if (mi == 5) { src = in[12] + (size_t)LP * 1024 * 2048; N = 2048; Nsub = 2048; dst = WgluT; mode = 1; }
          else continue;
        } else {
          if (mi == 4) { src = in[24] + (size_t)jp * 1024 * 1024; dst = WoT; mode = 3; }
          else if (mi == 5) { src = in[17] + (size_t)jp * 1024 * 1024; dst = WkvqT + (jp == 0 ? (size_t)2048 * 1024 : 0); gain = in[16] + jp * 1024; mode = 3; }
          else if (jp == 0) { src = in[14]; N = 2048; Nsub = 2048; dst = WkvqT; gain = in[13]; mode = 3; }
          else continue;
        }
        prep_mat(src, K, N, Nsub, dst, gain, mode, smf);
      }
    } else if (s == 1) {
      PHASE_PTRS
      if (isA) ph_win(XBCUR, ROWSS(3 * L), WinT, ug, smraw);
      else ph_kvq(XBCUR, ROWSS(3 * L), WkvqT, j == 0 ? 12 : 4, j == 0 ? 0 : 2048, in[15], in[18] + j * 64, Kb, Vt, QO, smraw);
      if (L >= 1) prep_mat(in[32] + (size_t)L * 1024 * 1024, 1024, 1024, 1024, WgtT, in[31] + L * 1024, 3, smf);
    } else if (s == 2) {
      PHASE_PTRS
      if (isA) ph_ssm_fused(ug, PT, YT, a16 + (size_t)L * 8192, Xc, in[11] + L * 1024, gy, smraw);
      else ph_attn(QO, (rep + 1 < nrep) ? (bf16_t*)(ws + 400 * MIB) : QO, Kb, Vt, tabg, in[15], in[19] + j * 64, in[20] + j * 64, in[21] + j * 64, in[22] + j * 64, in[23] + j * 128,
                   L, smraw);
    } else if (s == 3) {
      PHASE_PTRS
      ;
    } else if (s == 4) {
      PHASE_PTRS
      ;
    } else if (s == 5) {
      PHASE_PTRS
      if (isA) ph_wglu(gy, WgluT, XBCUR, ROWSS(3 * L + 1), smraw);
    } else if (s == 6) {
      PHASE_PTRS
      ph_halo_proj(XBCUR, ROWSS(3 * L + 1), WupT, halo, PBF, WpjT, XBNXT, smraw);
      ph_proj(PBF, WpjT, XBNXT, smraw);
    } else if (s == 7) {
      PHASE_PTRS
      ph_up(XBCUR, ROWSS(3 * L + 1), WupT, halo, in[28] + (size_t)L * 3 * 5632, in[29] + (size_t)L * 5632, act, smraw);
    } else if (s == 9) {
      PHASE_PTRS
      ph_ple(XBCUR, ROWSS(3 * L + 2), WgtT, x, XBNXT, ROWSS(3 * L + 3), true, smraw);
    }
    if (nrep > 1 && rep == 0 && P.coop) xcd_barrier(gbar);
    }
    if ((s == 3 && !isA) || s == 8) {
      PHASE_PTRS
      const bool dn = s == 8;
      ph_resid(dn ? act : QO, dn ? 2816 : 1024, dn ? WdnT : WoT, XBCUR, ROWSS(3 * L + (dn ? 2 : 1)), smraw);
    }
    if (P.coop && ph + 1 < P.ph_hi && !(!isA && (s == 4 || s == 5)) && !(isA && (s == 3 || s == 4)) && !(s == 0 && L > 0)) {
      if (P.coop == 2) cg::this_grid().sync();
      xcd_barrier(gbar);
      if (REPMASK & 1024) xcd_barrier(gbar);
    }
  }
}

extern "C" void kernel_launch(void* const* d_in, const int* in_sizes, int n_in, void* d_out, int out_size, void* d_ws, size_t ws_size,
                              hipStream_t stream) {
  static int grid_blocks = 0;
  if (!grid_blocks) {
    int dev = 0, cus = 0, per_cu = 0;
    (void)hipGetDevice(&dev);
    (void)hipDeviceGetAttribute(&cus, hipDeviceAttributeMultiprocessorCount, dev);
    if (hipFuncSetAttribute((const void*)yoco_mega, hipFuncAttributeMaxDynamicSharedMemorySize, LDS_BYTES) != hipSuccess)
      fprintf(stderr, "hipFuncSetAttribute(MaxDynamicSharedMemorySize) failed\n");
    (void)hipOccupancyMaxActiveBlocksPerMultiprocessor(&per_cu, (const void*)yoco_mega, NTHR, LDS_BYTES);
    if (per_cu < 1) { fprintf(stderr, "occupancy query says %d blocks/CU\n", per_cu); per_cu = 1; }
    if (per_cu > 1) per_cu = 1;
    grid_blocks = cus * per_cu;
    if (ws_size < WS_NEED) fprintf(stderr, "workspace too small: %zu < %llu\n", ws_size, (unsigned long long)WS_NEED);
  }
  Params P;
  memset(&P, 0, sizeof(P));
  for (int i = 0; i < 34; ++i) P.in[i] = (const float*)d_in[i];
  P.out = (float*)d_out;
  P.ws = (char*)d_ws;
#if MK_SINGLE
  P.ph_lo = 0; P.ph_hi = 40; P.coop = 1;
  (void)hipMemsetAsync((char*)d_ws + OFF_BAR, 0, XCD_BAR_WORDS * 4, stream);
  void* args[] = {&P};
  hipError_t e = hipLaunchCooperativeKernel((void*)yoco_mega, dim3(grid_blocks), dim3(NTHR), args, LDS_BYTES, stream);
  if (e != hipSuccess) fprintf(stderr, "cooperative launch failed: %s (grid %d)\n", hipGetErrorString(e), grid_blocks);
#else
  for (int ph = 0; ph < 40; ++ph) {
    const int L = ph / 10, s = ph % 10;
    if (L >= 2 && (s == 4 || s == 5)) continue;
    P.ph_lo = ph; P.ph_hi = ph + 1; P.coop = 0;
    hipLaunchKernelGGL(yoco_mega, dim3(grid_blocks), dim3(NTHR), LDS_BYTES, stream, P);
  }
#endif
}
```

```cpp
#include <hip/hip_runtime.h>
#include <hip/hip_cooperative_groups.h>
#include <stdint.h>
#include <stdio.h>
#include <string.h>
namespace cg = cooperative_groups;

typedef unsigned short bf16_t;
typedef short bf16x8 __attribute__((ext_vector_type(8)));
typedef float f32x4 __attribute__((ext_vector_type(4)));
typedef unsigned int u32x4 __attribute__((ext_vector_type(4)));
typedef unsigned int u32x2 __attribute__((ext_vector_type(2)));
typedef unsigned long long rss_t;
#define RSS_SCALE 16777216.f
#define LAS __attribute__((address_space(3)))

#ifndef REPMASK
#define REPMASK 0
#endif
#ifndef MK_SINGLE
#define MK_SINGLE 1
#endif

#define NTHR 512
#define LDS_BYTES 139264
#define EPSF 1e-6f
#define MIB (1ull << 20)
#define OFF_WIN  (0 * MIB)
#define OFF_WGLU (2 * MIB)
#define OFF_PT   (6 * MIB)
#define OFF_YT   (10 * MIB)
#define OFF_WKVQ (0 * MIB)
#define OFF_WO   (6 * MIB)
#define OFF_WUP  (22 * MIB)
#define OFF_WDN  (33 * MIB)
#define OFF_WGT  (39 * MIB)
#define OFF_WPJ  (41 * MIB)
#define OFF_SMALL (42 * MIB)
#define OFF_PBF  (46 * MIB)
#define OFF_XB0  (62 * MIB)
#define OFF_XB1  (126 * MIB)
#define OFF_UG   (190 * MIB)
#define OFF_S    (254 * MIB)
#define OFF_XC   (318 * MIB)
#define OFF_GY   (350 * MIB)
#define OFF_K    (190 * MIB)
#define OFF_VT   (254 * MIB)
#define OFF_QO   (318 * MIB)
#define OFF_ACT  (318 * MIB)
#define OFF_HALO (494 * MIB)
#define WS_NEED  (505 * MIB)

struct Params {
  const float* in[34];
  float* out;
  char* ws;
  int ph_lo, ph_hi, coop, pad;
};

__device__ __forceinline__ bf16_t f2bf(float f) {
  uint32_t u = __float_as_uint(f);
  u += 0x7fffu + ((u >> 16) & 1u);
  return (bf16_t)(u >> 16);
}
typedef __bf16 bf16v2 __attribute__((ext_vector_type(2)));
__device__ __forceinline__ uint32_t pack2(float a, float b) { bf16v2 v; v[0] = (__bf16)a; v[1] = (__bf16)b; return __builtin_bit_cast(uint32_t, v); }
__device__ __forceinline__ float bflo(uint32_t u) { return __uint_as_float(u << 16); }
__device__ __forceinline__ float bfhi(uint32_t u) { return __uint_as_float(u & 0xffff0000u); }
__device__ __forceinline__ float gelu_t(float x) {
  const float t = x * x;
  const float e = __builtin_amdgcn_exp2f(x * (-2.302208198f - 0.1029432397f * t));
  return x * __builtin_amdgcn_rcpf(1.f + e);
}
__device__ __forceinline__ float sigm(float x) { return __builtin_amdgcn_rcpf(1.f + __builtin_amdgcn_exp2f(-1.4426950408889634f * x)); }
__device__ __forceinline__ float sq4(f32x4 v) { return v[0] * v[0] + v[1] * v[1] + v[2] * v[2] + v[3] * v[3]; }

struct RowPlain {
  const bf16_t* A; int lda;
  __device__ __forceinline__ const char* base(int kt) const { return (const char*)(A + kt * 64); }
  __device__ __forceinline__ unsigned off(int row, int kt) const { return (unsigned)row * (unsigned)(lda * 2); }
};
struct RowHalo {
  const bf16_t* A; int ko;
  __device__ __forceinline__ const char* base(int kt) const { return (const char*)(A + (kt + ko) * 64); }
  __device__ __forceinline__ unsigned off(int row, int kt) const {
    int tok = 256 * (row >> 1) - 2 + (row & 1); tok = tok < 0 ? 0 : tok;
    return (unsigned)tok * 2048u;
  }
};
struct RowSsmY {
  const bf16_t* ugg; const bf16_t* xcg;
  __device__ __forceinline__ const char* base(int kt) const { return kt < 4 ? (const char*)(ugg + kt * 64) : (const char*)(xcg + (kt - 4) * 64); }
  __device__ __forceinline__ unsigned off(int row, int kt) const { return ((unsigned)row * 512u) << (kt < 4 ? 0 : 5); }
};

__device__ __forceinline__ const char* uni_ptr(const char* p) {
  const unsigned long long u = (unsigned long long)p;
  const unsigned lo = __builtin_amdgcn_readfirstlane((unsigned)u), hi = __builtin_amdgcn_readfirstlane((unsigned)(u >> 32));
  return (const char*)(((unsigned long long)hi << 32) | lo);
}
__device__ __forceinline__ int lds_byte(int r, int c) {
  const int st = (r >> 4) * 2 + (c >> 5), ob = (r & 15) * 64 + (c & 31) * 2;
  return st * 1024 + (ob ^ (((ob >> 9) & 1) << 5));
}
__device__ __forceinline__ void stage_rc(int b, int& R, int& C) {
  const int st = b >> 10, sb = b & 1023, swz = sb ^ (((sb >> 9) & 1) << 5);
  R = (st >> 1) * 16 + swz / 64;
  C = (st & 1) * 32 + (swz % 64) / 2;
}

template <class AR>
__device__ __forceinline__ void kloop(f32x4 (&acc)[8][4], const AR& ar, const bf16_t* __restrict__ Bt, int ldb, int m0, int n0, int nt, char* smem) {
  int tid_ = threadIdx.x; asm volatile("" : "+v"(tid_));
  const int tid = tid_, wid = tid >> 6, lane = tid & 63, wr = wid >> 2, wc = wid & 3, fr = lane & 15, fq = lane >> 4;
  int sR, sC; stage_rc(wid * 1024 + lane * 16, sR, sC);
  const unsigned sC2 = (unsigned)sC * 2u;
  const unsigned bo0 = ((unsigned)(n0 + sR) * (unsigned)ldb + (unsigned)sC) * 2u;
  const size_t bstep = (size_t)ldb * 128u;
  const int ar0 = m0 + sR;
  const unsigned ldsw = __builtin_amdgcn_readfirstlane((unsigned)(size_t)smem + (unsigned)wid * 1024u);
  __syncthreads();
#define GLDS16(ldsaddr, voff, sbase) asm volatile("s_mov_b32 m0, %0\n\tglobal_load_lds_dwordx4 %1, %2" :: "s"(ldsaddr), "v"(voff), "s"(sbase) : "memory")
#define GSTAGE(buf, kt) do { const char* ab_ = uni_ptr(ar.base(kt)); const char* bb_ = uni_ptr((const char*)(Bt + (kt) * 64)); _Pragma("unroll") for (int i = 0; i < 4; ++i) { \
    GLDS16(ldsw + (unsigned)((buf) * 65536 + i * 8192), ar.off(ar0 + 64 * i, (kt)) + sC2, ab_); \
    GLDS16(ldsw + (unsigned)((buf) * 65536 + 32768 + i * 8192), bo0, bb_ + bstep * i); } } while (0)
  GSTAGE(0, 0);
  asm volatile("s_waitcnt vmcnt(0)" ::: "memory");
  __syncthreads();
#pragma unroll 1
  for (int t = 0; t < nt; ++t) {
    const int cur = t & 1;
    if (t + 1 < nt) GSTAGE(cur ^ 1, t + 1);
    const char* sA = smem + cur * 65536;
    const char* sB = sA + 32768;
#pragma unroll
    for (int ks = 0; ks < 2; ++ks) {
      bf16x8 Bf[4], At[8];
#pragma unroll
      for (int n = 0; n < 4; ++n) Bf[n] = *(const bf16x8*)(sB + lds_byte(wc * 64 + n * 16 + fr, ks * 32 + fq * 8));
#pragma unroll
      for (int m = 0; m < 8; ++m) At[m] = *(const bf16x8*)(sA + lds_byte(wr * 128 + m * 16 + fr, ks * 32 + fq * 8));
#pragma unroll
      for (int m = 0; m < 8; ++m)
#pragma unroll
        for (int n = 0; n < 4; ++n) acc[m][n] = __builtin_amdgcn_mfma_f32_16x16x32_bf16(Bf[n], At[m], acc[m][n], 0, 0, 0);
      __builtin_amdgcn_sched_group_barrier(0x100, 8, 0);
      __builtin_amdgcn_sched_group_barrier(0x008, 4, 0);
      __builtin_amdgcn_sched_group_barrier(0x100, 2, 0);
      __builtin_amdgcn_sched_group_barrier(0x008, 4, 0);
      __builtin_amdgcn_sched_group_barrier(0x100, 2, 0);
      __builtin_amdgcn_sched_group_barrier(0x008, 24, 0);
      __builtin_amdgcn_sched_barrier(0);
    }
    asm volatile("s_waitcnt vmcnt(0)" ::: "memory");
    __syncthreads();
  }
#undef GSTAGE
#undef GLDS16
}

__device__ __forceinline__ void tile_map(int L, int nM, int nN, int& pm, int& pn) {
  const int q = (nM * nN) >> 3;
  const int wgid = (L & 7) * q + (L >> 3);
  const int nig = 8 * nN, gid = wgid / nig, r = wgid - gid * nig;
  pm = gid * 8 + (r & 7); pn = r >> 3;
}
__device__ __forceinline__ void zero_acc(f32x4 (&acc)[8][4]) {
#pragma unroll
  for (int m = 0; m < 8; ++m)
#pragma unroll
    for (int n = 0; n < 4; ++n) acc[m][n] = (f32x4){0.f, 0.f, 0.f, 0.f};
}

__device__ __forceinline__ int srccol(int n, int mode) {
  if (mode == 1) { const int q64 = n >> 6, f = (n >> 4) & 3, i = n & 15; const int oc = 32 * q64 + 8 * (i >> 2) + 4 * (f >> 1) + (i & 3);
                   return (f & 1) ? 1024 + oc : oc; }
  if (mode == 2) { const int rho = n & 31, nn = rho >> 4, i = rho & 15; const int np = (n & ~31) + 8 * (i >> 2) + 4 * nn + (i & 3);
                   const int nt = np >> 8, j = np & 255; return j < 128 ? nt * 128 + j : 2816 + nt * 128 + (j - 128); }
  if (mode == 3) { const int rho = n & 31, nn = rho >> 4, i = rho & 15; return (n & ~31) + 8 * (i >> 2) + 4 * nn + (i & 3); }
  return n;
}
__device__ __forceinline__ void prep_mat(const float* __restrict__ src, int K, int N, int Nsub, bf16_t* __restrict__ dst, const float* __restrict__ gain, int mode, float* smf) {
  int tid_ = threadIdx.x; asm volatile("" : "+v"(tid_)); const int tid = tid_;
  const int KT = K >> 6, NT = Nsub >> 6, ntile = KT * NT;
  const int j = tid & 63, kq = tid >> 6;
  float v[8];
  int t = blockIdx.x;
  if (t < ntile) {
    const int k0 = (t % KT) * 64, n0 = (t / KT) * 64; const int sc = srccol(n0 + j, mode);
#pragma unroll
    for (int i = 0; i < 8; ++i) { const int k = i * 8 + kq; v[i] = src[(size_t)(k0 + k) * N + sc] * (gain ? gain[k0 + k] : 1.f); }
  }
  for (; t < ntile; t += gridDim.x) {
    const int k0 = (t % KT) * 64, n0 = (t / KT) * 64;
    __syncthreads();
#pragma unroll
    for (int i = 0; i < 8; ++i) smf[(i * 8 + kq) * 65 + j] = v[i];
    const int tn = t + gridDim.x;
    if (tn < ntile) {
      const int k1 = (tn % KT) * 64, n1 = (tn / KT) * 64; const int sc = srccol(n1 + j, mode);
#pragma unroll
      for (int i = 0; i < 8; ++i) { const int k = i * 8 + kq; v[i] = src[(size_t)(k1 + k) * N + sc] * (gain ? gain[k1 + k] : 1.f); }
    }
    __syncthreads();
    {
      const int row = tid >> 3, kv = tid & 7;
      float w[8];
#pragma unroll
      for (int e = 0; e < 8; ++e) w[e] = smf[(kv * 8 + e) * 65 + row];
      u32x4 o; o.x = pack2(w[0], w[1]); o.y = pack2(w[2], w[3]); o.z = pack2(w[4], w[5]); o.w = pack2(w[6], w[7]);
      *(u32x4*)(dst + (size_t)(n0 + row) * K + k0 + kv * 8) = o;
    }
  }
}

__device__ __forceinline__ void ssm_consts(const float* log_dt, const float* lam_re, const float* lam_im, float* ssmc, float* a16p, int L, int g, int p) {
  const float dt = expf(log_dt[L * 64 + g]);
  const float lr = lam_re[L * 4096 + g * 64 + p], li = lam_im[L * 4096 + g * 64 + p];
  const float mag = expf(lr * dt);
  const float abr = mag * cosf(li * dt), abi = mag * sinf(li * dt);
  const float den = lr * lr + li * li;
  const float fr = ((abr - 1.f) * lr + abi * li) / den;
  const float fi = (abi * lr - (abr - 1.f) * li) / den;
  *(f32x4*)(ssmc + (size_t)((L * 64 + g) * 64 + p) * 4) = (f32x4){abr, abi, fr, fi};
  float xr = abr, xi = abi;
#pragma unroll
  for (int q = 0; q < 4; ++q) { float nr = xr * xr - xi * xi, ni = 2.f * xr * xi; xr = nr; xi = ni; }
  a16p[(size_t)L * 8192 + (g * 64 + p) * 2] = xr; a16p[(size_t)L * 8192 + (g * 64 + p) * 2 + 1] = xi;
}

__device__ __forceinline__ void prep_ssm(const float* ssmcL, const float* b_re, const float* b_im,
                         const float* c_re, const float* c_im, bf16_t* PT, bf16_t* YT, float* smf) {
  int tid_ = threadIdx.x; asm volatile("" : "+v"(tid_)); const int tid = tid_;
  float* s_abr = smf; float* s_abi = smf + 64; float* s_fr = smf + 128; float* s_fi = smf + 192;
  float* s_pr = smf + 256; float* s_pi = smf + 320;
  for (int g = blockIdx.x; g < 64; g += gridDim.x) {
    __syncthreads();
    if (tid < 64) {
      const f32x4 cc = *(const f32x4*)(ssmcL + (size_t)(g * 64 + tid) * 4);
      s_abr[tid] = cc[0]; s_abi[tid] = cc[1]; s_fr[tid] = cc[2]; s_fi[tid] = cc[3];
      s_pr[tid] = 1.f; s_pi[tid] = 0.f;
    }
    __syncthreads();
    if (tid < 256) {
      const int co = tid >> 4, ci = tid & 15;
      bf16_t* yg = YT + (size_t)g * 256 * 384;
      float kj[16];
#pragma unroll
      for (int j = 0; j < 16; ++j) kj[j] = 0.f;
#pragma unroll 2
      for (int p = 0; p < 64; ++p) {
        const float br = b_re[(g * 64 + p) * 16 + ci], bi = b_im[(g * 64 + p) * 16 + ci];
        const float fr = s_fr[p], fi = s_fi[p], ar = s_abr[p], ai = s_abi[p];
        const float bbr = fr * br - fi * bi, bbi = fr * bi + fi * br;
        const float cr = c_re[(g * 16 + co) * 64 + p], cim = c_im[(g * 16 + co) * 64 + p];
        float zr = cr * bbr - cim * bbi, zi = cr * bbi + cim * bbr;
#pragma unroll
        for (int j = 0; j < 16; ++j) { kj[j] += zr; const float nr = zr * ar - zi * ai, ni = zr * ai + zi * ar; zr = nr; zi = ni; }
      }
#pragma unroll
      for (int j = 0; j < 16; ++j) {
        const bf16_t v = f2bf(kj[j]);
#pragma unroll 1
        for (int t = j; t < 16; ++t) yg[(t * 16 + co) * 384 + (t - j) * 16 + ci] = v;
        if (j > 0) {
#pragma unroll 1
          for (int t = 0; t + j < 16; ++t) yg[(t * 16 + co) * 384 + (t + j) * 16 + ci] = 0;
        }
      }
    }
    {
      bf16_t* yg = YT + (size_t)g * 256 * 384;
#pragma unroll 1
      for (int i = 0; i < 2; ++i) {
        const int idx = tid + 512 * i, co = idx >> 6, p = idx & 63;
        const float ar = s_abr[p], ai = s_abi[p];
        float zr = c_re[(g * 16 + co) * 64 + p], zi = c_im[(g * 16 + co) * 64 + p];
#pragma unroll 1
        for (int t = 0; t < 16; ++t) {
          const float nr = zr * ar - zi * ai, ni = zr * ai + zi * ar; zr = nr; zi = ni;
          yg[(t * 16 + co) * 384 + 256 + p] = f2bf(zr);
          yg[(t * 16 + co) * 384 + 320 + p] = f2bf(-zi);
        }
      }
    }
    {
      bf16_t* pg = PT + (size_t)g * 128 * 256;
#pragma unroll 1
      for (int i = 0; i < 2; ++i) {
        const int idx = tid + 512 * i, p = idx >> 4, c = idx & 15;
        const float ar = s_abr[p], ai = s_abi[p], fr = s_fr[p], fi = s_fi[p];
        const float br = b_re[(g * 64 + p) * 16 + c], bi = b_im[(g * 64 + p) * 16 + c];
        float zr = fr * br - fi * bi, zi = fr * bi + fi * br;
#pragma unroll 1
        for (int t = 15; t >= 0; --t) {
          pg[p * 256 + t * 16 + c] = f2bf(zr);
          pg[(64 + p) * 256 + t * 16 + c] = f2bf(zi);
          const float nr = zr * ar - zi * ai, ni = zr * ai + zi * ar; zr = nr; zi = ni;
        }
      }
    }
  }
}

__device__ __forceinline__ void prep_bias(const float* rel_bias, float* tab) {
  if (blockIdx.x == 0) {
    int tid_ = threadIdx.x; asm volatile("" : "+v"(tid_));
    for (int idx = tid_; idx < 8 * 129; idx += NTHR) {
      const int h = idx / 129, n = idx % 129;
      int bucket;
      if (n < 16) bucket = n;
      else {
        bucket = 16 + (n >= 19) + (n >= 21) + (n >= 24) + (n >= 27) + (n >= 31) + (n >= 35) + (n >= 40) + (n >= 46) + (n >= 52) + (n >= 59)
                 + (n >= 67) + (n >= 77) + (n >= 87) + (n >= 99) + (n >= 113);
      }
      tab[h * 132 + n] = rel_bias[bucket * 8 + h] * 1.4426950408889634f;
    }
    if (tid_ < 8) {
      float mx = -1e30f;
      for (int bk = 0; bk < 32; ++bk) mx = fmaxf(mx, rel_bias[bk * 8 + tid_] * 1.4426950408889634f);
      tab[tid_ * 132 + 129] = mx;
    }
  }
}

__device__ __forceinline__ void prep_x(const float* xin, bf16_t* xbuf, rss_t* rowss) {
  int tid_ = threadIdx.x; asm volatile("" : "+v"(tid_)); const int tid = tid_, wid = tid >> 6, lane = tid & 63;
  for (int i = blockIdx.x * NTHR + tid; i < 12 * 32768; i += gridDim.x * NTHR) rowss[32768 + i] = 0ull;
#pragma unroll 2
  for (int row = blockIdx.x * 8 + wid; row < 32768; row += gridDim.x * 8) {
    float ss = 0.f;
#pragma unroll
    for (int i = 0; i < 2; ++i) {
      const f32x4* p = (const f32x4*)(xin + (size_t)row * 1024 + i * 512 + lane * 8);
      const f32x4 a = p[0], b = p[1];
      u32x4 o; o.x = pack2(a[0], a[1]); o.y = pack2(a[2], a[3]); o.z = pack2(b[0], b[1]); o.w = pack2(b[2], b[3]);
      *(u32x4*)(xbuf + (size_t)row * 1024 + i * 512 + lane * 8) = o;
      ss += sq4(a) + sq4(b);
    }
#pragma unroll
    for (int o = 32; o >= 1; o >>= 1) ss += __shfl_xor(ss, o);
    if (lane == 0) rowss[row] = (rss_t)(ss * RSS_SCALE + 0.5f);
  }
}
__device__ __forceinline__ void prep_p(const float* pin, bf16_t* pbf) {
  int tid_ = threadIdx.x; asm volatile("" : "+v"(tid_));
#pragma unroll 4
  for (size_t i = (size_t)blockIdx.x * NTHR + tid_; i < (size_t)32768 * 256 / 8; i += (size_t)gridDim.x * NTHR) {
    const f32x4* p = (const f32x4*)(pin + i * 8);
    const f32x4 a = p[0], b = p[1];
    u32x4 o; o.x = pack2(a[0], a[1]); o.y = pack2(a[2], a[3]); o.z = pack2(b[0], b[1]); o.w = pack2(b[2], b[3]);
    *(u32x4*)(pbf + i * 8) = o;
  }
}

#define ROWL(m) (wr * 128 + (m) * 16 + lr)
#define COLL(n) (wc * 64 + (n) * 16 + lq * 4)
#define COLP(p) (wc * 64 + (p) * 32 + lq * 8)
#define LANE_IDS int tid_ = threadIdx.x; asm volatile("" : "+v"(tid_)); const int tid = tid_, lane = tid & 63, wid = tid >> 6, wr = wid >> 2, wc = wid & 3; (void)tid; (void)lane; (void)wr; (void)wc;
#define EPI_IDS int lq = lane >> 4, lr = lane & 15; asm volatile("" : "+v"(lq), "+v"(lr));
#define RSTD(rs, row) rsqrtf((float)(rs)[row] * (1.f / (1024.f * RSS_SCALE)) + EPSF)
#define RSS_ADD(p, v) atomicAdd((p), (rss_t)((v) * RSS_SCALE + 0.5f))

__device__ __forceinline__ void ph_win(const bf16_t* xbp, const rss_t* rs, const bf16_t* Wt, bf16_t* ugp, char* smem) {
  LANE_IDS
  RowPlain ar{xbp, 1024};
  for (int t = blockIdx.x; t < 128 * 4; t += gridDim.x) {
    int mt, nt; tile_map(t, 128, 4, mt, nt); const int m0 = mt * 256, n0 = nt * 256;
    f32x4 acc[8][4]; zero_acc(acc);
    kloop(acc, ar, Wt, 1024, m0, n0, 16, smem);
    EPI_IDS
#pragma unroll
    for (int m = 0; m < 8; ++m) {
      const int tok = m0 + ROWL(m);
      const float rstd = RSTD(rs, tok);
#pragma unroll
      for (int p = 0; p < 2; ++p) {
        const int c0 = n0 + COLP(p), g = c0 >> 4;
        const f32x4 v0 = acc[m][2 * p] * rstd, v1 = acc[m][2 * p + 1] * rstd;
        u32x4 o; o.x = pack2(v0[0], v0[1]); o.y = pack2(v0[2], v0[3]); o.z = pack2(v1[0], v1[1]); o.w = pack2(v1[2], v1[3]);
        *(u32x4*)(ugp + ((size_t)(g * 2048 + (tok >> 4)) * 256 + (tok & 15) * 16 + (c0 & 15))) = o;
      }
    }
  }
}

__device__ __forceinline__ void ph_sstate(const bf16_t* ugp, const bf16_t* PTp, float* S, char* smem) {
  LANE_IDS
  for (int t = blockIdx.x; t < 64 * 8; t += gridDim.x) {
    const int g = t >> 3, mt = t & 7, m0 = mt * 256;
    RowPlain ar{ugp + (size_t)g * 2048 * 256, 256};
    f32x4 acc[8][4]; zero_acc(acc);
    kloop(acc, ar, PTp + (size_t)g * 128 * 256, 256, m0, 0, 4, smem);
    EPI_IDS
    if (wc < 2) {
#pragma unroll
      for (int m = 0; m < 8; ++m) {
        const int row = m0 + ROWL(m);
#pragma unroll
        for (int n = 0; n < 4; ++n) *(f32x4*)(S + ((size_t)row * 64 + g) * 128 + COLL(n)) = acc[m][n];
      }
    }
  }
}

__device__ __forceinline__ void ph_scan(const float* S, const float* a16p, bf16_t* Xcp) {
  int tid_ = threadIdx.x; asm volatile("" : "+v"(tid_));
  for (int idx = blockIdx.x * NTHR + tid_; idx < 16 * 64 * 64; idx += gridDim.x * NTHR) {
    const int p = idx & 63, g = (idx >> 6) & 63, b = idx >> 12;
    const float ar = a16p[(g * 64 + p) * 2], ai = a16p[(g * 64 + p) * 2 + 1];
    float xr = 0.f, xi = 0.f;
#pragma unroll 8
    for (int c = 0; c < 128; ++c) {
      const size_t off = ((size_t)(b * 128 + c) * 64 + g) * 128;
      Xcp[off + p] = f2bf(xr); Xcp[off + 64 + p] = f2bf(xi);
      const float sr = S[off + p], si = S[off + 64 + p];
      const float nr = ar * xr - ai * xi + sr, ni = ar * xi + ai * xr + si;
      xr = nr; xi = ni;
    }
  }
}

__device__ __forceinline__ void ph_ssmy(const bf16_t* ugp, const bf16_t* Xcp, const bf16_t* YTp, const float* dskip, bf16_t* gyp, char* smem) {
  LANE_IDS
  for (int t = blockIdx.x; t < 64 * 8; t += gridDim.x) {
    const int g = t >> 3, mt = t & 7, m0 = mt * 256;
    const bf16_t* ugg = ugp + (size_t)g * 2048 * 256;
    RowSsmY ar{ugg, Xcp + (size_t)g * 128};
    f32x4 acc[8][4]; zero_acc(acc);
    kloop(acc, ar, YTp + (size_t)g * 256 * 384, 384, m0, 0, 6, smem);
    EPI_IDS
    const f32x4 dv = *(const f32x4*)(dskip + g * 16 + lq * 4);
#pragma unroll
    for (int m = 0; m < 8; ++m) {
      asm volatile("" ::: "memory");
      const int row = m0 + ROWL(m);
#pragma unroll
      for (int n = 0; n < 4; ++n) {
        const int tt = wc * 4 + n;
        const u32x2 uu = *(const u32x2*)(ugg + (size_t)row * 256 + tt * 16 + lq * 4);
        f32x4 y = acc[m][n];
        y[0] += dv[0] * bflo(uu.x); y[1] += dv[1] * bfhi(uu.x); y[2] += dv[2] * bflo(uu.y); y[3] += dv[3] * bfhi(uu.y);
        u32x2 o; o.x = pack2(gelu_t(y[0]), gelu_t(y[1])); o.y = pack2(gelu_t(y[2]), gelu_t(y[3]));
        *(u32x2*)(gyp + (size_t)(row * 16 + tt) * 1024 + g * 16 + lq * 4) = o;
      }
    }
  }
}

__device__ __forceinline__ void ph_ssm_fused(const bf16_t* ugp, const bf16_t* PTp, const bf16_t* YTp, const float* a16p, bf16_t* Xcp,
                                             const float* dskip, bf16_t* gyp, char* smem) {
  LANE_IDS
  float* Sl = (float*)smem;
  for (int t = blockIdx.x; t < 64 * 8; t += gridDim.x) {
    const int g = t >> 3, mt = t & 7, m0 = mt * 256;
    const bf16_t* ugg = ugp + (size_t)g * 2048 * 256;
    {
      RowPlain ar{ugg, 256};
      f32x4 acc[8][4]; zero_acc(acc);
      kloop(acc, ar, PTp + (size_t)g * 128 * 256, 256, m0, 0, 4, smem);
      EPI_IDS
      if (wc < 2) {
#pragma unroll
        for (int m = 0; m < 8; ++m)
#pragma unroll
          for (int n = 0; n < 4; ++n) *(f32x4*)(Sl + ROWL(m) * 128 + COLL(n)) = acc[m][n];
      }
    }
    __syncthreads();
    if (tid < 128) {
      const int bb = tid >> 6, p = tid & 63;
      const float ar_ = a16p[(g * 64 + p) * 2], ai_ = a16p[(g * 64 + p) * 2 + 1];
      float xr = 0.f, xi = 0.f;
      bf16_t* xo = Xcp + ((size_t)(m0 + bb * 128) * 64 + g) * 128;
      const float* sl = Sl + (bb * 128) * 128;
#pragma unroll 8
      for (int c = 0; c < 128; ++c) {
        xo[(size_t)c * 8192 + p] = f2bf(xr); xo[(size_t)c * 8192 + 64 + p] = f2bf(xi);
        const float sr = sl[c * 128 + p], si = sl[c * 128 + 64 + p];
        const float nr = ar_ * xr - ai_ * xi + sr, ni = ar_ * xi + ai_ * xr + si;
        xr = nr; xi = ni;
      }
    }
    __builtin_amdgcn_fence(__ATOMIC_RELEASE, "workgroup");
    asm volatile("s_waitcnt vmcnt(0)" ::: "memory");
    __syncthreads();
    {
      RowSsmY ar{ugg, Xcp + (size_t)g * 128};
      f32x4 acc[8][4]; zero_acc(acc);
      kloop(acc, ar, YTp + (size_t)g * 256 * 384, 384, m0, 0, 6, smem);
      EPI_IDS
      const f32x4 dv = *(const f32x4*)(dskip + g * 16 + lq * 4);
#pragma unroll
      for (int m = 0; m < 8; ++m) {
        asm volatile("" ::: "memory");
        const int row = m0 + ROWL(m);
#pragma unroll
        for (int n = 0; n < 4; ++n) {
          const int tt = wc * 4 + n;
          const u32x2 uu = *(const u32x2*)(ugg + (size_t)row * 256 + tt * 16 + lq * 4);
          f32x4 y = acc[m][n];
          y[0] += dv[0] * bflo(uu.x); y[1] += dv[1] * bfhi(uu.x); y[2] += dv[2] * bflo(uu.y); y[3] += dv[3] * bfhi(uu.y);
          u32x2 o; o.x = pack2(gelu_t(y[0]), gelu_t(y[1])); o.y = pack2(gelu_t(y[2]), gelu_t(y[3]));
          *(u32x2*)(gyp + (size_t)(row * 16 + tt) * 1024 + g * 16 + lq * 4) = o;
        }
      }
    }
  }
}

__device__ __forceinline__ void ph_wglu(const bf16_t* gyp, const bf16_t* Wt, bf16_t* xbp, rss_t* rso, char* smem) {
  LANE_IDS
  RowPlain ar{gyp, 1024};
  for (int t = blockIdx.x; t < 128 * 8; t += gridDim.x) {
    int mt, nt; tile_map(t, 128, 8, mt, nt); const int m0 = mt * 256, n0 = nt * 256;
    f32x4 acc[8][4]; zero_acc(acc);
    kloop(acc, ar, Wt, 1024, m0, n0, 16, smem);
    EPI_IDS
    const int oc = ((n0 + wc * 64) >> 1) + lq * 8;
    u32x4 xq[2];
#pragma unroll
    for (int m = 0; m < 2; ++m) xq[m] = *(const u32x4*)(xbp + (size_t)(m0 + ROWL(m)) * 1024 + oc);
#pragma unroll
    for (int m = 0; m < 8; ++m) {
      const int row = m0 + ROWL(m);
      const size_t rowoff = (size_t)row * 1024;
      asm volatile("" ::: "memory");
      const u32x4 xr = xq[m & 1];
      f32x4 xa = (f32x4){bflo(xr.x), bfhi(xr.x), bflo(xr.y), bfhi(xr.y)}, xc = (f32x4){bflo(xr.z), bfhi(xr.z), bflo(xr.w), bfhi(xr.w)};
#pragma unroll
      for (int r = 0; r < 4; ++r) { xa[r] += acc[m][0][r] * sigm(acc[m][1][r]); xc[r] += acc[m][2][r] * sigm(acc[m][3][r]); }
      u32x4 o; o.x = pack2(xa[0], xa[1]); o.y = pack2(xa[2], xa[3]); o.z = pack2(xc[0], xc[1]); o.w = pack2(xc[2], xc[3]);
      *(u32x4*)(xbp + rowoff + oc) = o;
      float ss = sq4(xa) + sq4(xc);
      if (m + 2 < 8) xq[m & 1] = *(const u32x4*)(xbp + (size_t)(m0 + ROWL(m + 2)) * 1024 + oc);
      ss += __shfl_xor(ss, 16); ss += __shfl_xor(ss, 32);
      if (lq == 0) RSS_ADD(rso + row, ss);
    }
  }
}

__device__ __forceinline__ void ph_resid(const bf16_t* A, int K, const bf16_t* Bt, bf16_t* xbp, rss_t* rso, char* smem) {
  LANE_IDS
  RowPlain ar{A, K};
  for (int t = blockIdx.x; t < 128 * 4; t += gridDim.x) {
    int mt, nt; tile_map(t, 128, 4, mt, nt); const int m0 = mt * 256, n0 = nt * 256;
    f32x4 acc[8][4]; zero_acc(acc);
    kloop(acc, ar, Bt, K, m0, n0, K >> 6, smem);
    EPI_IDS
    u32x4 xq[2][2];
#pragma unroll
    for (int m = 0; m < 2; ++m)
#pragma unroll
      for (int p = 0; p < 2; ++p) xq[m][p] = *(const u32x4*)(xbp + (size_t)(m0 + ROWL(m)) * 1024 + n0 + COLP(p));
#pragma unroll
    for (int m = 0; m < 8; ++m) {
      const int row = m0 + ROWL(m);
      const size_t rowoff = (size_t)row * 1024;
      float ss = 0.f;
      asm volatile("" ::: "memory");
#pragma unroll
      for (int p = 0; p < 2; ++p) {
        const int oc = n0 + COLP(p);
        const u32x4 xr = xq[m & 1][p];
        f32x4 xa = acc[m][2 * p], xc = acc[m][2 * p + 1];
        xa[0] += bflo(xr.x); xa[1] += bfhi(xr.x); xa[2] += bflo(xr.y); xa[3] += bfhi(xr.y);
        xc[0] += bflo(xr.z); xc[1] += bfhi(xr.z); xc[2] += bflo(xr.w); xc[3] += bfhi(xr.w);
        u32x4 o; o.x = pack2(xa[0], xa[1]); o.y = pack2(xa[2], xa[3]); o.z = pack2(xc[0], xc[1]); o.w = pack2(xc[2], xc[3]);
        *(u32x4*)(xbp + rowoff + oc) = o;
        ss += sq4(xa) + sq4(xc);
      }
      if (m + 2 < 8) {
#pragma unroll
        for (int p = 0; p < 2; ++p) xq[m & 1][p] = *(const u32x4*)(xbp + (size_t)(m0 + ROWL(m + 2)) * 1024 + n0 + COLP(p));
      }
      ss += __shfl_xor(ss, 16); ss += __shfl_xor(ss, 32);
      if (lq == 0) RSS_ADD(rso + row, ss);
    }
  }
}

__device__ __forceinline__ void ph_halo_proj(const bf16_t* xbp, const rss_t* rs, const bf16_t* WupTp, float* halop, const bf16_t* pbf, const bf16_t* WpjTp, bf16_t* pj, char* smem) {
  LANE_IDS
  for (int t = blockIdx.x; t < 44; t += gridDim.x) {
    f32x4 acc[8][4]; zero_acc(acc);
    const int nt = t >> 1, kh = t & 1, m0 = 0, n0 = nt * 256;
    RowHalo ar{xbp, kh * 8};
    kloop(acc, ar, WupTp + kh * 512, 1024, m0, n0, 8, smem);
    EPI_IDS
#pragma unroll
    for (int m = 0; m < 8; ++m) {
      const int r = m0 + ROWL(m);
      int tok = 256 * (r >> 1) - 2 + (r & 1); tok = tok < 0 ? 0 : tok;
      const float rstd = RSTD(rs, tok);
#pragma unroll
      for (int n = 0; n < 4; ++n) *(f32x4*)(halop + (size_t)kh * 256 * 5632 + (size_t)r * 5632 + n0 + COLP(n >> 1) + (n & 1) * 4) = acc[m][n] * rstd;
    }
  }
}
__device__ __forceinline__ void ph_proj(const bf16_t* pbf, const bf16_t* WpjTp, bf16_t* pj, char* smem) {
  LANE_IDS
  for (int t = gridDim.x - 1 - blockIdx.x; t < 512; t += gridDim.x) {
    f32x4 acc[8][4]; zero_acc(acc);
    int mt, nt; tile_map(t, 128, 4, mt, nt); const int m0 = mt * 256, n0 = nt * 256;
    RowPlain ar{pbf, 256};
    kloop(acc, ar, WpjTp, 256, m0, n0, 4, smem);
    EPI_IDS
#pragma unroll
    for (int m = 0; m < 8; ++m) {
      const size_t rowoff = (size_t)(m0 + ROWL(m)) * 1024;
#pragma unroll
      for (int p = 0; p < 2; ++p) {
        const f32x4 a0 = acc[m][2 * p], a1 = acc[m][2 * p + 1];
        u32x4 o; o.x = pack2(a0[0], a0[1]); o.y = pack2(a0[2], a0[3]); o.z = pack2(a1[0], a1[1]); o.w = pack2(a1[2], a1[3]);
        *(u32x4*)(pj + rowoff + n0 + COLP(p)) = o;
      }
    }
  }
}

__device__ __forceinline__ void ph_up(const bf16_t* xbp, const rss_t* rs, const bf16_t* WupTp, const float* halop, const float* convw, const float* convb, bf16_t* actp, char* smem) {
  LANE_IDS
  RowPlain ar{xbp, 1024};
  bf16_t* st = (bf16_t*)(smem + 1024);
  for (int t = blockIdx.x; t < 128 * 22; t += gridDim.x) {
    int mt, nt; tile_map(t, 128, 22, mt, nt); const int m0 = mt * 256, n0 = nt * 256;
    f32x4 acc[8][4]; zero_acc(acc);
    kloop(acc, ar, WupTp, 1024, m0, n0, 16, smem);
    EPI_IDS
#pragma unroll
    for (int m = 0; m < 8; ++m) {
      const float rstd = RSTD(rs, m0 + ROWL(m));
#pragma unroll
      for (int p = 0; p < 2; ++p) {
        const f32x4 v0 = acc[m][2 * p] * rstd, v1 = acc[m][2 * p + 1] * rstd;
        u32x4 o; o.x = pack2(v0[0], v0[1]); o.y = pack2(v0[2], v0[3]); o.z = pack2(v1[0], v1[1]); o.w = pack2(v1[2], v1[3]);
        *(u32x4*)(st + (2 + ROWL(m)) * 256 + COLP(p)) = o;
      }
    }
    {
      const int j = tid >> 8, col = tid & 255;
      float hv = 0.f;
      if ((m0 & 2047) != 0) hv = halop[(size_t)(2 * mt + j) * 5632 + n0 + col] + halop[(size_t)256 * 5632 + (size_t)(2 * mt + j) * 5632 + n0 + col];
      st[j * 256 + col] = f2bf(hv);
    }
    __syncthreads();
    {
      const int cp = tid & 31, rg = tid >> 5;
      const int hc = nt * 128 + 4 * cp;
      float wg[3][4], wv[3][4], bg[4], bv[4];
#pragma unroll
      for (int j = 0; j < 3; ++j) {
        const f32x4 a = *(const f32x4*)(convw + j * 5632 + hc), c = *(const f32x4*)(convw + j * 5632 + 2816 + hc);
#pragma unroll
        for (int e = 0; e < 4; ++e) { wg[j][e] = a[e]; wv[j][e] = c[e]; }
      }
      {
        const f32x4 a = *(const f32x4*)(convb + hc), c = *(const f32x4*)(convb + 2816 + hc);
#pragma unroll
        for (int e = 0; e < 4; ++e) { bg[e] = a[e]; bv[e] = c[e]; }
      }
      const int r0 = rg * 16;
      u32x2 g2 = *(const u32x2*)(st + (r0) * 256 + 4 * cp), v2 = *(const u32x2*)(st + (r0) * 256 + 128 + 4 * cp);
      u32x2 g1 = *(const u32x2*)(st + (r0 + 1) * 256 + 4 * cp), v1 = *(const u32x2*)(st + (r0 + 1) * 256 + 128 + 4 * cp);
#pragma unroll 4
      for (int r = 0; r < 16; ++r) {
        const u32x2 g0 = *(const u32x2*)(st + (r0 + r + 2) * 256 + 4 * cp), v0 = *(const u32x2*)(st + (r0 + r + 2) * 256 + 128 + 4 * cp);
        float o4[4];
#pragma unroll
        for (int e = 0; e < 4; ++e) {
          const uint32_t wg2 = (e < 2) ? g2.x : g2.y, wg1 = (e < 2) ? g1.x : g1.y, wg0 = (e < 2) ? g0.x : g0.y;
          const uint32_t wv2 = (e < 2) ? v2.x : v2.y, wv1 = (e < 2) ? v1.x : v1.y, wv0 = (e < 2) ? v0.x : v0.y;
          const float a2 = (e & 1) ? bfhi(wg2) : bflo(wg2), a1 = (e & 1) ? bfhi(wg1) : bflo(wg1), a0 = (e & 1) ? bfhi(wg0) : bflo(wg0);
          const float c2 = (e & 1) ? bfhi(wv2) : bflo(wv2), c1 = (e & 1) ? bfhi(wv1) : bflo(wv1), c0 = (e & 1) ? bfhi(wv0) : bflo(wv0);
          const float cg = bg[e] + wg[0][e] * a2 + wg[1][e] * a1 + wg[2][e] * a0;
          const float cv = bv[e] + wv[0][e] * c2 + wv[1][e] * c1 + wv[2][e] * c0;
          o4[e] = gelu_t(cg) * cv;
        }
        u32x2 o; o.x = pack2(o4[0], o4[1]); o.y = pack2(o4[2], o4[3]);
        *(u32x2*)(actp + (size_t)(m0 + r0 + r) * 2816 + hc) = o;
        g2 = g1; g1 = g0; v2 = v1; v1 = v0;
      }
    }
  }
}

__device__ __forceinline__ void ph_ple(const bf16_t* xbp, const rss_t* rs, const bf16_t* WgtTp, float* xout, bf16_t* xnx, rss_t* rso, bool last, char* smem) {
  LANE_IDS
  RowPlain ar{xbp, 1024};
  for (int t = blockIdx.x; t < 128 * 4; t += gridDim.x) {
    int mt, nt; tile_map(t, 128, 4, mt, nt); const int m0 = mt * 256, n0 = nt * 256;
    f32x4 acc[8][4]; zero_acc(acc);
    kloop(acc, ar, WgtTp, 1024, m0, n0, 16, smem);
    EPI_IDS
    u32x4 xq[2][2], pq[2][2]; float rq[2];
#pragma unroll
    for (int m = 0; m < 2; ++m) {
      rq[m] = RSTD(rs, m0 + ROWL(m));
#pragma unroll
      for (int p = 0; p < 2; ++p) {
        xq[m][p] = *(const u32x4*)(xbp + (size_t)(m0 + ROWL(m)) * 1024 + n0 + COLP(p));
        pq[m][p] = *(const u32x4*)(xnx + (size_t)(m0 + ROWL(m)) * 1024 + n0 + COLP(p));
      }
    }
#pragma unroll
    for (int m = 0; m < 8; ++m) {
      const int row = m0 + ROWL(m);
      const size_t rowoff = (size_t)row * 1024;
      float ss = 0.f;
      asm volatile("" ::: "memory");
      const float rstd = rq[m & 1];
#pragma unroll
      for (int p = 0; p < 2; ++p) {
        const int oc = n0 + COLP(p);
        const u32x4 xr = xq[m & 1][p];
        const u32x4 pp = pq[m & 1][p];
        const f32x4 g0 = acc[m][2 * p], g1 = acc[m][2 * p + 1];
        f32x4 xa, xc;
        xa[0] = bflo(xr.x) + sigm(g0[0] * rstd) * bflo(pp.x);
        xa[1] = bfhi(xr.x) + sigm(g0[1] * rstd) * bfhi(pp.x);
        xa[2] = bflo(xr.y) + sigm(g0[2] * rstd) * bflo(pp.y);
        xa[3] = bfhi(xr.y) + sigm(g0[3] * rstd) * bfhi(pp.y);
        xc[0] = bflo(xr.z) + sigm(g1[0] * rstd) * bflo(pp.z);
        xc[1] = bfhi(xr.z) + sigm(g1[1] * rstd) * bfhi(pp.z);
        xc[2] = bflo(xr.w) + sigm(g1[2] * rstd) * bflo(pp.w);
        xc[3] = bfhi(xr.w) + sigm(g1[3] * rstd) * bfhi(pp.w);
        if (last) { *(f32x4*)(xout + rowoff + oc) = xa; *(f32x4*)(xout + rowoff + oc + 4) = xc; }
        else {
          u32x4 o; o.x = pack2(xa[0], xa[1]); o.y = pack2(xa[2], xa[3]); o.z = pack2(xc[0], xc[1]); o.w = pack2(xc[2], xc[3]);
          *(u32x4*)(xnx + rowoff + oc) = o;
          ss += sq4(xa) + sq4(xc);
        }
      }
      if (m + 2 < 8) {
        rq[m & 1] = RSTD(rs, m0 + ROWL(m + 2));
#pragma unroll
        for (int p = 0; p < 2; ++p) {
          xq[m & 1][p] = *(const u32x4*)(xbp + (size_t)(m0 + ROWL(m + 2)) * 1024 + n0 + COLP(p));
          pq[m & 1][p] = *(const u32x4*)(xnx + (size_t)(m0 + ROWL(m + 2)) * 1024 + n0 + COLP(p));
        }
      }
      if (!last) {
        ss += __shfl_xor(ss, 16); ss += __shfl_xor(ss, 32);
        if (lq == 0) RSS_ADD(rso + row, ss);
      }
    }
  }
}

__device__ __forceinline__ void ph_kvq(const bf16_t* xbp, const rss_t* rs, const bf16_t* Wt, int NT, int coloff, const float* knorm, const float* qnorm,
                       bf16_t* Kbp, bf16_t* Vtp, bf16_t* Qbp, char* smem) {
  LANE_IDS
  RowPlain ar{xbp, 1024};
  const float qscale = 0.125f * 1.4426950408889634f;
  for (int t = blockIdx.x; t < 128 * NT; t += gridDim.x) {
    int mt, nt; tile_map(t, 128, NT, mt, nt); const int m0 = mt * 256, n0 = nt * 256;
    f32x4 acc[8][4]; zero_acc(acc);
    kloop(acc, ar, Wt, 1024, m0, n0, 16, smem);
    EPI_IDS
    const int cw = coloff + n0 + wc * 64;
#pragma unroll
    for (int m = 0; m < 8; ++m) {
      const int tok = m0 + ROWL(m);
      const float rstd = RSTD(rs, tok);
      f32x4 v[4];
      float ss = 0.f;
#pragma unroll
      for (int n = 0; n < 4; ++n) { v[n] = acc[m][n] * rstd; ss += sq4(v[n]); }
      if (cw >= 1024 && cw < 2048) {
        const int b = tok >> 11, tt = tok & 2047;
#pragma unroll
        for (int n = 0; n < 4; ++n)
#pragma unroll
          for (int r = 0; r < 4; ++r) {
            const int j = cw - 1024 + (n >> 1) * 32 + lq * 8 + (n & 1) * 4 + r;
            Vtp[((size_t)(b * 1024 + j)) * 2048 + tt] = f2bf(v[n][r]);
          }
      } else {
        ss += __shfl_xor(ss, 16); ss += __shfl_xor(ss, 32);
        const bool isq = cw >= 2048;
        const float hn = rsqrtf(ss * (1.f / 64.f) + EPSF) * (isq ? qscale : 1.f);
        const float* gn = isq ? qnorm : knorm;
        bf16_t* dst = isq ? (Qbp + (size_t)tok * 1024 + (cw - 2048)) : (Kbp + (size_t)tok * 1024 + cw);
#pragma unroll
        for (int p = 0; p < 2; ++p) {
          const int d0 = p * 32 + lq * 8;
          const f32x4 g0 = *(const f32x4*)(gn + d0), g1 = *(const f32x4*)(gn + d0 + 4);
          const f32x4 a0 = v[2 * p] * hn * g0, a1 = v[2 * p + 1] * hn * g1;
          u32x4 o; o.x = pack2(a0[0], a0[1]); o.y = pack2(a0[2], a0[3]); o.z = pack2(a1[0], a1[1]); o.w = pack2(a1[2], a1[3]);
          *(u32x4*)(dst + d0) = o;
        }
      }
    }
  }
}

#define ATT_COMPUTE(KT_, KST_) do { \
_Pragma("unroll 1") \
      for (int hf = 0; hf < 2; ++hf) { \
        const int key0 = (KT_) * 64 + hf * 32; \
        if (key0 > q0 + wid * 16 + 15) break;     \
        const char* Ks = KST_ + hf * 32 * 272; \
        const char* Vs = KST_ + 17408 + hf * 64; \
        const bool far = (q0 + wid * 16 - (key0 + 31)) >= 128;       \
        const bool diag = key0 + 31 > q0 + wid * 16;                 \
        float bias[2][4]; \
        if (!far) { \
_Pragma("unroll") \
          for (int nf = 0; nf < 2; ++nf) \
_Pragma("unroll") \
            for (int r = 0; r < 4; ++r) { \
              const int dist = qpos - (key0 + lq * 8 + nf * 4 + r); \
              const int idx = dist < 0 ? 0 : (dist > 128 ? 128 : dist); \
              bias[nf][r] = (diag && dist < 0) ? -1e30f : tab[idx]; \
            } \
        } else { \
_Pragma("unroll") \
          for (int nf = 0; nf < 2; ++nf) \
_Pragma("unroll") \
            for (int r = 0; r < 4; ++r) bias[nf][r] = bfar; \
        } \
          \
        __builtin_amdgcn_sched_barrier(0);     \
        bf16x8 kfa[2][2], kfb[2][2]; \
_Pragma("unroll") \
        for (int nf = 0; nf < 2; ++nf) \
_Pragma("unroll") \
          for (int ks = 0; ks < 2; ++ks) \
            kfa[nf][ks] = *(const bf16x8*)(Ks + (8 * (lr >> 2) + 4 * nf + (lr & 3)) * 272 + (ks * 32 + lq * 8) * 2);     \
        __builtin_amdgcn_sched_barrier(0);     \
        f32x4 sa[2], sb[2]; \
_Pragma("unroll") \
        for (int nf = 0; nf < 2; ++nf) { \
          f32x4 a = (f32x4){bias[nf][0] - mb[0], bias[nf][1] - mb[0], bias[nf][2] - mb[0], bias[nf][3] - mb[0]};     \
_Pragma("unroll") \
          for (int ks = 0; ks < 2; ++ks) a = __builtin_amdgcn_mfma_f32_16x16x32_bf16(kfa[nf][ks], qf[0][ks], a, 0, 0, 0); \
          sa[nf] = a; \
_Pragma("unroll") \
          for (int ks = 0; ks < 2; ++ks) \
            kfb[nf][ks] = *(const bf16x8*)(Ks + (8 * (lr >> 2) + 4 * nf + (lr & 3)) * 272 + (64 + ks * 32 + lq * 8) * 2); \
        } \
        __builtin_amdgcn_sched_barrier(0);     \
        bf16x8 vfa[4], vfb[4]; \
_Pragma("unroll") \
        for (int nf = 0; nf < 2; ++nf) { \
          f32x4 a = (f32x4){bias[nf][0] - mb[1], bias[nf][1] - mb[1], bias[nf][2] - mb[1], bias[nf][3] - mb[1]}; \
_Pragma("unroll") \
          for (int ks = 0; ks < 2; ++ks) a = __builtin_amdgcn_mfma_f32_16x16x32_bf16(kfb[nf][ks], qf[1][ks], a, 0, 0, 0); \
          sb[nf] = a; \
        } \
_Pragma("unroll") \
        for (int ef = 0; ef < 4; ++ef) vfa[ef] = *(const bf16x8*)(Vs + (ef * 16 + lr) * 144 + lq * 16); \
        bf16x8 pk[2]; \
        { float ps0 = 0.f, ps1 = 0.f; \
_Pragma("unroll") \
          for (int nf = 0; nf < 2; ++nf) \
_Pragma("unroll") \
            for (int r = 0; r < 4; ++r) { \
              const float p0 = __builtin_amdgcn_exp2f(sa[nf][r]);     \
              const float p1 = __builtin_amdgcn_exp2f(sb[nf][r]); \
              sa[nf][r] = p0; sb[nf][r] = p1; ps0 += p0; ps1 += p1; \
            } \
          lrun[0] += ps0; lrun[1] += ps1; \
          union { uint32_t u[4]; bf16x8 v; } cvt; \
          cvt.u[0] = pack2(sa[0][0], sa[0][1]); cvt.u[1] = pack2(sa[0][2], sa[0][3]); cvt.u[2] = pack2(sa[1][0], sa[1][1]); cvt.u[3] = pack2(sa[1][2], sa[1][3]); \
          pk[0] = cvt.v; \
          cvt.u[0] = pack2(sb[0][0], sb[0][1]); cvt.u[1] = pack2(sb[0][2], sb[0][3]); cvt.u[2] = pack2(sb[1][0], sb[1][1]); cvt.u[3] = pack2(sb[1][2], sb[1][3]); \
          pk[1] = cvt.v; } \
        __builtin_amdgcn_sched_barrier(0);     \
_Pragma("unroll") \
        for (int ef = 0; ef < 4; ++ef) { \
          oacc[0][ef] = __builtin_amdgcn_mfma_f32_16x16x32_bf16(vfa[ef], pk[0], oacc[0][ef], 0, 0, 0); \
          oacc[1][ef] = __builtin_amdgcn_mfma_f32_16x16x32_bf16(vfa[ef], pk[1], oacc[1][ef], 0, 0, 0); \
          vfb[ef] = *(const bf16x8*)(Vs + ((ef + 4) * 16 + lr) * 144 + lq * 16); \
        } \
        __builtin_amdgcn_sched_barrier(0);     \
_Pragma("unroll") \
        for (int ef = 0; ef < 4; ++ef) { \
          oacc[0][ef + 4] = __builtin_amdgcn_mfma_f32_16x16x32_bf16(vfb[ef], pk[0], oacc[0][ef + 4], 0, 0, 0); \
          oacc[1][ef + 4] = __builtin_amdgcn_mfma_f32_16x16x32_bf16(vfb[ef], pk[1], oacc[1][ef + 4], 0, 0, 0); \
        } \
        __builtin_amdgcn_sched_barrier(0); \
      } \
      } while (0)
__device__ __forceinline__ void ph_attn(const bf16_t* Qin, bf16_t* Oout, const bf16_t* Kbp, const bf16_t* Vtp, const float* tabgp, const float* knorm, const float* lq1, const float* lk1,
                        const float* lq2, const float* lk2, const float* subln, int Lidx, char* smc) {
  LANE_IDS
  const int lq = lane >> 4, lr = lane & 15;
  float* tab = (float*)smc;
  char* stg = smc + 1024;
  float s1 = 0.f, s2 = 0.f, kmax = 0.f;
  for (int d = 0; d < 64; ++d) { s1 += lq1[d] * lk1[d]; s2 += lq2[d] * lk2[d]; kmax = fmaxf(kmax, fabsf(knorm[d])); }
  asm volatile("" : "+s"(Lidx));
  const float lam_init = (Lidx == 2) ? 0.47071302f : 0.55605820f;
  const float lam = expf(s1) - expf(s2) + lam_init;
  const float osc = 1.f - lam_init;
  const float kb = 8.08f * kmax;
  for (int w = blockIdx.x; w < 2048; w += gridDim.x) {
    const int i8 = w & 255, k8 = w >> 8, xcd = i8 & 7, slot = i8 >> 3, jq = slot & 15;
    const int bh = xcd + 8 * (2 * k8 + (slot >> 4));
    const int qb = (k8 & 1) ? (15 - jq) : jq;
    const int b = bh >> 3, h = bh & 7;
    const int q0 = qb * 128, tb = b * 2048;
    const int qpos = q0 + wid * 16 + lr;
    const bf16_t* kbase = Kbp + (size_t)tb * 1024 + h * 128;
    const bf16_t* vbase = Vtp + (size_t)(b * 8 + h) * 128 * 2048;
    const int nkt = 2 * (qb + 1);
    u32x4 kr0[2], vr0[2], kr1[2], vr1[2];
    if (tid < 130) tab[tid] = tabgp[h * 132 + tid];
    bf16x8 qf[2][2];
    float mb[2];
#pragma unroll
    for (int c = 0; c < 2; ++c) {
      float ss = 0.f;
#pragma unroll
      for (int ks = 0; ks < 2; ++ks) {
        const u32x4 qq = *(const u32x4*)(Qin + (size_t)(tb + qpos) * 1024 + h * 128 + c * 64 + ks * 32 + lq * 8);
        union { u32x4 u; bf16x8 v; } cv; cv.u = qq; qf[c][ks] = cv.v;
        ss += bflo(qq.x) * bflo(qq.x) + bfhi(qq.x) * bfhi(qq.x) + bflo(qq.y) * bflo(qq.y) + bfhi(qq.y) * bfhi(qq.y)
            + bflo(qq.z) * bflo(qq.z) + bfhi(qq.z) * bfhi(qq.z) + bflo(qq.w) * bflo(qq.w) + bfhi(qq.w) * bfhi(qq.w);
      }
      ss += __shfl_xor(ss, 16); ss += __shfl_xor(ss, 32);
      mb[c] = sqrtf(ss) * kb;
    }
#define ATT_LOAD(KR, VR, ST) do { _Pragma("unroll") for (int i = 0; i < 2; ++i) { const int v = tid + 512 * i; \
      KR[i] = *(const u32x4*)(kbase + (size_t)((ST) * 64 + (v >> 4)) * 1024 + (v & 15) * 8); \
      VR[i] = *(const u32x4*)(vbase + (size_t)(v >> 3) * 2048 + (ST) * 64 + (v & 7) * 8); } } while (0)
#define ATT_WRITE(KR, VR, BUF) do { char* Kn_ = stg + (BUF) * 35840; _Pragma("unroll") for (int i = 0; i < 2; ++i) { const int v = tid + 512 * i; \
      *(u32x4*)(Kn_ + (v >> 4) * 272 + (v & 15) * 16) = KR[i]; \
      *(u32x4*)(Kn_ + 17408 + (v >> 3) * 144 + (v & 7) * 16) = VR[i]; } } while (0)
    ATT_LOAD(kr0, vr0, 0);
    ATT_LOAD(kr1, vr1, 1);
    ATT_WRITE(kr0, vr0, 0);
    if (nkt > 2) ATT_LOAD(kr0, vr0, 2);
    __syncthreads();
    const float bmax = tab[129];
    const float bfar = tab[128];
    mb[0] += bmax; mb[1] += bmax;
    f32x4 oacc[2][8];
#pragma unroll
    for (int c = 0; c < 2; ++c)
#pragma unroll
      for (int e = 0; e < 8; ++e) oacc[c][e] = (f32x4){0.f, 0.f, 0.f, 0.f};
    float lrun[2] = {0.f, 0.f};
    for (int kt = 0; kt < nkt; kt += 2) {
      ATT_COMPUTE(kt, stg);
      ATT_WRITE(kr1, vr1, 1);
      if (kt + 3 < nkt) ATT_LOAD(kr1, vr1, kt + 3);
      __syncthreads();
      ATT_COMPUTE(kt + 1, (stg + 35840));
      if (kt + 2 < nkt) ATT_WRITE(kr0, vr0, 0);
      if (kt + 4 < nkt) ATT_LOAD(kr0, vr0, kt + 4);
      __syncthreads();
    }
#undef ATT_LOAD
#undef ATT_WRITE
    float l0 = lrun[0], l1 = lrun[1];
    l0 += __shfl_xor(l0, 16); l0 += __shfl_xor(l0, 32);
    l1 += __shfl_xor(l1, 16); l1 += __shfl_xor(l1, 32);
    const float i0 = 1.f / l0, i1 = lam / l1;
    float ss = 0.f;
#pragma unroll
    for (int e = 0; e < 8; ++e) {
      oacc[0][e] = oacc[0][e] * i0 - oacc[1][e] * i1;
      ss += sq4(oacc[0][e]);
    }
    ss += __shfl_xor(ss, 16); ss += __shfl_xor(ss, 32);
    const float rn = rsqrtf(ss * (1.f / 128.f) + EPSF) * osc;
#pragma unroll
    for (int e = 0; e < 8; ++e) {
      const f32x4 gv = *(const f32x4*)(subln + e * 16 + lq * 4);
      const f32x4 o = oacc[0][e] * rn * gv;
      u32x2 wv; wv.x = pack2(o[0], o[1]); wv.y = pack2(o[2], o[3]);
      *(u32x2*)(Oout + (size_t)(tb + qpos) * 1024 + h * 128 + e * 16 + lq * 4) = wv;
    }
  }
}

#define XB_TMO      128
#define XB_XCNT(j)  (256  + 64 * (j))
#define XB_XSUB(j)  (1280 + 64 * (j))
#define XB_XGEN(j)  (2304 + 64 * (j))
#define XB_TOP      3328
#define XB_TOPGEN   3392
#define XCD_BAR_WORDS 3456
#define XB_SPIN_CAP (1u << 18)

__device__ __forceinline__ unsigned xb_ld(unsigned* p)              { return __hip_atomic_load(p, __ATOMIC_RELAXED, __HIP_MEMORY_SCOPE_AGENT); }
__device__ __forceinline__ unsigned xb_add(unsigned* p, unsigned v) { return __hip_atomic_fetch_add(p, v, __ATOMIC_RELAXED, __HIP_MEMORY_SCOPE_AGENT); }
__device__ __forceinline__ unsigned xb_xcc_id() { return (unsigned)__builtin_amdgcn_s_getreg((3 << 11) | 20) & 0xFu; }
#define XB_SPIN(cond, bar) do { unsigned _sp = 0; while (cond) { __builtin_amdgcn_s_sleep(1); \
    if ((++_sp & 255u) == 0u) { if (xb_ld(&(bar)[XB_TMO])) break; if (_sp > XB_SPIN_CAP) { atomicAdd(&(bar)[XB_TMO], 1u); break; } } } } while (0)

struct XcdBarrier {
    unsigned* bar; unsigned x;
    volatile LAS unsigned* st;
};

__device__ __forceinline__ XcdBarrier xcd_barrier_post(unsigned* bar, volatile LAS unsigned* st) {
    XcdBarrier b; b.bar = bar; b.x = xb_xcc_id(); b.st = st;
    if (threadIdx.x == 0) (void)xb_add(&bar[XB_XCNT(b.x)], 1u);
    return b;
}
__device__ __forceinline__ void xcd_barrier_complete(unsigned* bar, unsigned x, unsigned& nloc, unsigned& nx) {
    const unsigned G = gridDim.x * gridDim.y * gridDim.z;
    unsigned sum, cnt, mine, sp = 0u;
    for (;;) {
        sum = 0u; cnt = 0u; mine = 0u;
#pragma unroll
        for (unsigned j = 0; j < 16; ++j) { const unsigned c = xb_ld(&bar[XB_XCNT(j)]); sum += c; cnt += (c > 0u) ? 1u : 0u; mine = (j == x) ? c : mine; }
        if (sum == G) break;
        __builtin_amdgcn_s_sleep(1);
        if ((++sp & 255u) == 0u) { if (xb_ld(&bar[XB_TMO])) break; if (sp > XB_SPIN_CAP) { atomicAdd(&bar[XB_TMO], 1u); break; } }
    }
    nloc = mine > 0u ? mine : 1u; nx = cnt > 0u ? cnt : 1u;
}

__device__ __forceinline__ void xcd_barrier(const XcdBarrier& b) {
    asm volatile("s_waitcnt vmcnt(0)" ::: "memory");
    __syncthreads();
    if (threadIdx.x == 0) {
        unsigned* bar = b.bar;
        __builtin_amdgcn_s_waitcnt(0);
        unsigned nloc = b.st[0], nx = b.st[1];
        if (nloc == 0u) { xcd_barrier_complete(bar, b.x, nloc, nx); b.st[0] = nloc; b.st[1] = nx; }
        const unsigned old = xb_add(&bar[XB_XSUB(b.x)], 1u);
        const unsigned gen = old / nloc;
        if (old + 1u == (gen + 1u) * nloc) {
            __builtin_amdgcn_fence(__ATOMIC_RELEASE, "agent");
            asm volatile("s_waitcnt vmcnt(0)" ::: "memory");
            const unsigned og = xb_add(&bar[XB_TOP], 1u);
            const unsigned tg = og / nx;
            if (og + 1u == (tg + 1u) * nx) xb_add(&bar[XB_TOPGEN], 1u);
            else XB_SPIN(xb_ld(&bar[XB_TOPGEN]) == tg, bar);
            __builtin_amdgcn_fence(__ATOMIC_ACQUIRE, "agent");
            xb_add(&bar[XB_XGEN(b.x)], 1u);
            asm volatile("s_waitcnt vmcnt(0)" ::: "memory");
        } else {
            XB_SPIN(xb_ld(&bar[XB_XGEN(b.x)]) == gen, bar);
            __builtin_amdgcn_fence(__ATOMIC_ACQUIRE, "agent");
            asm volatile("s_waitcnt vmcnt(0)" ::: "memory");
        }
    }
    __syncthreads();
}

#define PHASE_PTRS int z = 0; asm volatile("" : "+s"(z)); char* ws = P.ws + z; const float* const* in = P.in + z; float* x = P.out + z; (void)ws; (void)in; (void)x;
#define WinT ((bf16_t*)(ws + OFF_WIN))
#define WgluT ((bf16_t*)(ws + OFF_WGLU))
#define PT ((bf16_t*)(ws + OFF_PT))
#define YT ((bf16_t*)(ws + OFF_YT))
#define WkvqT ((bf16_t*)(ws + OFF_WKVQ))
#define WoT ((bf16_t*)(ws + OFF_WO))
#define WupT ((bf16_t*)(ws + OFF_WUP))
#define WdnT ((bf16_t*)(ws + OFF_WDN))
#define WgtT ((bf16_t*)(ws + OFF_WGT))
#define WpjT ((bf16_t*)(ws + OFF_WPJ))
#define a16 ((float*)(ws + OFF_SMALL))
#define tabg ((float*)(ws + OFF_SMALL + 65536))
#define SSMC ((float*)(ws + OFF_SMALL + 3584 * 1024))
#define OFF_BAR (OFF_SMALL + 3840 * 1024)
#define ROWSS(v) ((rss_t*)(ws + OFF_SMALL + 131072) + (size_t)(v) * 32768)
#define PBF ((bf16_t*)(ws + OFF_PBF))
#define XBCUR ((bf16_t*)(ws + ((L & 1) ? OFF_XB1 : OFF_XB0)))
#define XBNXT ((bf16_t*)(ws + ((L & 1) ? OFF_XB0 : OFF_XB1)))
#define ug ((bf16_t*)(ws + OFF_UG))
#define S_ ((float*)(ws + OFF_S))
#define Xc ((bf16_t*)(ws + OFF_XC))
#define gy ((bf16_t*)(ws + OFF_GY))
#define Kb ((bf16_t*)(ws + OFF_K))
#define Vt ((bf16_t*)(ws + OFF_VT))
#define QO ((bf16_t*)(ws + OFF_QO))
#define act ((bf16_t*)(ws + OFF_ACT))
#define halo ((float*)(ws + OFF_HALO))
__global__ void __launch_bounds__(NTHR, 2) yoco_mega(Params P) {
  extern __shared__ __attribute__((aligned(1024))) char smraw[];
  float* smf = (float*)smraw;
  volatile LAS unsigned* bst = (volatile LAS unsigned*)(LAS char*)(smraw + 139200);
  if (threadIdx.x == 0) { bst[0] = 0u; bst[1] = 0u; }
  __syncthreads();
  XcdBarrier gbar; gbar.bar = (unsigned*)(P.ws + OFF_BAR); gbar.x = 0; gbar.st = bst;
  if (P.coop) gbar = xcd_barrier_post((unsigned*)(P.ws + OFF_BAR), bst);
  if (P.ph_lo == 0 && blockIdx.x < 64) {
    PHASE_PTRS
    int tid_ = threadIdx.x; asm volatile("" : "+v"(tid_));
    if (tid_ < 128) ssm_consts(in[4], in[5], in[6], SSMC, a16, tid_ >> 6, blockIdx.x, tid_ & 63);
    __threadfence();
  }
  for (int ph = P.ph_lo; ph < P.ph_hi; ++ph) {
    const int L = ph / 10, s = ph % 10;
    const bool isA = L < 2;
    const int j = L - 2;
    const int nrep = ((REPMASK >> s) & 1) ? 2 : 1;
    for (int rep = 0; rep < nrep; ++rep) {
    if ((s == 0 && L == 0) || (s == 9 && L < 3)) {
      PHASE_PTRS
      const int LP = (s == 0) ? 0 : L + 1;
      const bool pA = LP < 2; const int jp = LP - 2;
      if (s == 9) ph_ple(XBCUR, ROWSS(3 * L + 2), WgtT, x, XBNXT, ROWSS(3 * L + 3), false, smraw);
      if (LP == 0) prep_x(in[0], (bf16_t*)(ws + OFF_XB0), ROWSS(0));
      prep_p(in[1] + (size_t)LP * 32768 * 256, PBF);
      if (pA) prep_ssm(SSMC + (size_t)LP * 16384, in[7] + (size_t)LP * 65536, in[8] + (size_t)LP * 65536,
                       in[9] + (size_t)LP * 65536, in[10] + (size_t)LP * 65536, PT, YT, smf);
      else if (jp == 0) prep_bias(in[25], tabg);
#pragma unroll 1
      for (int mi = 0; mi < 7; ++mi) {
        const float* src = nullptr; const float* gain = nullptr; bf16_t* dst = nullptr; int K = 1024, N = 1024, Nsub = 1024, mode = 0;
        if (mi == 0) { src = in[27] + (size_t)LP * 1024 * 5632; N = 5632; Nsub = 5632; dst = WupT; gain = in[26] + LP * 1024; mode = 2; }
        else if (mi == 1) { src = in[30] + (size_t)LP * 2816 * 1024; K = 2816; dst = WdnT; mode = 3; }
        else if (mi == 2) { if (LP != 0) continue; src = in[32]; dst = WgtT; gain = in[31]; mode = 3; }
        else if (mi == 3) { src = in[33] + (size_t)LP * 256 * 1024; K = 256; dst = WpjT; mode = 3; }
        else if (pA) {
          if (mi == 4) { src = in[3] + (size_t)LP * 1024 * 1024; dst = WinT; gain = in[2] + LP * 1024; mode = 3; }
          else if (mi == 5) { src = in[12] + (size_t)LP * 1024 * 2048; N = 2048; Nsub = 2048; dst = WgluT; mode = 1; }
          else continue;
        } else {
          if (mi == 4) { src = in[24] + (size_t)jp * 1024 * 1024; dst = WoT; mode = 3; }
          else if (mi == 5) { src = in[17] + (size_t)jp * 1024 * 1024; dst = WkvqT + (jp == 0 ? (size_t)2048 * 1024 : 0); gain = in[16] + jp * 1024; mode = 3; }
          else if (jp == 0) { src = in[14]; N = 2048; Nsub = 2048; dst = WkvqT; gain = in[13]; mode = 3; }
          else continue;
        }
        prep_mat(src, K, N, Nsub, dst, gain, mode, smf);
      }
    } else if (s == 1) {
      PHASE_PTRS
      if (isA) ph_win(XBCUR, ROWSS(3 * L), WinT, ug, smraw);
      else ph_kvq(XBCUR, ROWSS(3 * L), WkvqT, j == 0 ? 12 : 4, j == 0 ? 0 : 2048, in[15], in[18] + j * 64, Kb, Vt, QO, smraw);
      if (L >= 1) prep_mat(in[32] + (size_t)L * 1024 * 1024, 1024, 1024, 1024, WgtT, in[31] + L * 1024, 3, smf);
    } else if (s == 2) {
      PHASE_PTRS
      if (isA) ph_ssm_fused(ug, PT, YT, a16 + (size_t)L * 8192, Xc, in[11] + L * 1024, gy, smraw);
      else ph_attn(QO, (rep + 1 < nrep) ? (bf16_t*)(ws + 400 * MIB) : QO, Kb, Vt, tabg, in[15], in[19] + j * 64, in[20] + j * 64, in[21] + j * 64, in[22] + j * 64, in[23] + j * 128,
                   L, smraw);
    } else if (s == 3) {
      PHASE_PTRS
      ;
    } else if (s == 4) {
      PHASE_PTRS
      ;
    } else if (s == 5) {
      PHASE_PTRS
      if (isA) ph_wglu(gy, WgluT, XBCUR, ROWSS(3 * L + 1), smraw);
    } else if (s == 6) {
      PHASE_PTRS
      ph_halo_proj(XBCUR, ROWSS(3 * L + 1), WupT, halo, PBF, WpjT, XBNXT, smraw);
      ph_proj(PBF, WpjT, XBNXT, smraw);
    } else if (s == 7) {
      PHASE_PTRS
      ph_up(XBCUR, ROWSS(3 * L + 1), WupT, halo, in[28] + (size_t)L * 3 * 5632, in[29] + (size_t)L * 5632, act, smraw);
    } else if (s == 9) {
      PHASE_PTRS
      ph_ple(XBCUR, ROWSS(3 * L + 2), WgtT, x, XBNXT, ROWSS(3 * L + 3), true, smraw);
    }
    if (nrep > 1 && rep == 0 && P.coop) xcd_barrier(gbar);
    }
    if ((s == 3 && !isA) || s == 8) {
      PHASE_PTRS
      const bool dn = s == 8;
      ph_resid(dn ? act : QO, dn ? 2816 : 1024, dn ? WdnT : WoT, XBCUR, ROWSS(3 * L + (dn ? 2 : 1)), smraw);
    }
    if (P.coop && ph + 1 < P.ph_hi && !(!isA && (s == 4 || s == 5)) && !(isA && (s == 3 || s == 4)) && !(s == 0 && L > 0)) {
      if (P.coop == 2) cg::this_grid().sync();
      xcd_barrier(gbar);
      if (REPMASK & 1024) xcd_barrier(gbar);
    }
  }
}

extern "C" void kernel_launch(void* const* d_in, const int* in_sizes, int n_in, void* d_out, int out_size, void* d_ws, size_t ws_size,
                              hipStream_t stream) {
  static int grid_blocks = 0;
  if (!grid_blocks) {
    int dev = 0, cus = 0, per_cu = 0;
    (void)hipGetDevice(&dev);
    (void)hipDeviceGetAttribute(&cus, hipDeviceAttributeMultiprocessorCount, dev);
    if (hipFuncSetAttribute((const void*)yoco_mega, hipFuncAttributeMaxDynamicSharedMemorySize, LDS_BYTES) != hipSuccess)
      fprintf(stderr, "hipFuncSetAttribute(MaxDynamicSharedMemorySize) failed\n");
    (void)hipOccupancyMaxActiveBlocksPerMultiprocessor(&per_cu, (const void*)yoco_mega, NTHR, LDS_BYTES);
    if (per_cu < 1) { fprintf(stderr, "occupancy query says %d blocks/CU\n", per_cu); per_cu = 1; }
    if (per_cu > 1) per_cu = 1;
    grid_blocks = cus * per_cu;
    if (ws_size < WS_NEED) fprintf(stderr, "workspace too small: %zu < %llu\n", ws_size, (unsigned long long)WS_NEED);
  }
  Params P;
  memset(&P, 0, sizeof(P));
  for (int i = 0; i < 34; ++i) P.in[i] = (const float*)d_in[i];
  P.out = (float*)d_out;
  P.ws = (char*)d_ws;
#if MK_SINGLE
  P.ph_lo = 0; P.ph_hi = 40; P.coop = 1;
  (void)hipMemsetAsync((char*)d_ws + OFF_BAR, 0, XCD_BAR_WORDS * 4, stream);
  void* args[] = {&P};
  hipError_t e = hipLaunchCooperativeKernel((void*)yoco_mega, dim3(grid_blocks), dim3(NTHR), args, LDS_BYTES, stream);
  if (e != hipSuccess) fprintf(stderr, "cooperative launch failed: %s (grid %d)\n", hipGetErrorString(e), grid_blocks);
#else
  for (int ph = 0; ph < 40; ++ph) {
    const int L = ph / 10, s = ph % 10;
    if (L >= 2 && (s == 4 || s == 5)) continue;
    P.ph_lo = ph; P.ph_hi = ph + 1; P.coop = 0;
    hipLaunchKernelGGL(yoco_mega, dim3(grid_blocks), dim3(NTHR), LDS_BYTES, stream, P);
  }
#endif
}
```

```cpp
#include <hip/hip_runtime.h>
#include <hip/hip_cooperative_groups.h>
#include <stdint.h>
#include <stdio.h>
#include <string.h>
namespace cg = cooperative_groups;

typedef unsigned short bf16_t;
typedef short bf16x8 __attribute__((ext_vector_type(8)));
typedef float f32x4 __attribute__((ext_vector_type(4)));
typedef unsigned int u32x4 __attribute__((ext_vector_type(4)));
typedef unsigned int u32x2 __attribute__((ext_vector_type(2)));
typedef unsigned long long rss_t;
#define RSS_SCALE 16777216.f
#define LAS __attribute__((address_space(3)))

#ifndef REPMASK
#define REPMASK 0
#endif
#ifndef MK_SINGLE
#define MK_SINGLE 1
#endif

#define NTHR 512
#define LDS_BYTES 139264
#define EPSF 1e-6f
#define MIB (1ull << 20)
#define OFF_WIN  (0 * MIB)
#define OFF_WGLU (2 * MIB)
#define OFF_PT   (6 * MIB)
#define OFF_YT   (10 * MIB)
#define OFF_WKVQ (0 * MIB)
#define OFF_WO   (6 * MIB)
#define OFF_WUP  (22 * MIB)
#define OFF_WDN  (33 * MIB)
#define OFF_WGT  (39 * MIB)
#define OFF_WPJ  (41 * MIB)
#define OFF_SMALL (42 * MIB)
#define OFF_PBF  (46 * MIB)
#define OFF_XB0  (62 * MIB)
#define OFF_XB1  (126 * MIB)
#define OFF_UG   (190 * MIB)
#define OFF_S    (254 * MIB)
#define OFF_XC   (318 * MIB)
#define OFF_GY   (350 * MIB)
#define OFF_K    (190 * MIB)
#define OFF_VT   (254 * MIB)
#define OFF_QO   (318 * MIB)
#define OFF_ACT  (318 * MIB)
#define OFF_HALO (494 * MIB)
#define WS_NEED  (505 * MIB)

struct Params {
  const float* in[34];
  float* out;
  char* ws;
  int ph_lo, ph_hi, coop, pad;
};

__device__ __forceinline__ bf16_t f2bf(float f) {
  uint32_t u = __float_as_uint(f);
  u += 0x7fffu + ((u >> 16) & 1u);
  return (bf16_t)(u >> 16);
}
typedef __bf16 bf16v2 __attribute__((ext_vector_type(2)));
__device__ __forceinline__ uint32_t pack2(float a, float b) { bf16v2 v; v[0] = (__bf16)a; v[1] = (__bf16)b; return __builtin_bit_cast(uint32_t, v); }
__device__ __forceinline__ float bflo(uint32_t u) { return __uint_as_float(u << 16); }
__device__ __forceinline__ float bfhi(uint32_t u) { return __uint_as_float(u & 0xffff0000u); }
__device__ __forceinline__ float gelu_t(float x) {
  const float t = x * x;
  const float e = __builtin_amdgcn_exp2f(x * (-2.302208198f - 0.1029432397f * t));
  return x * __builtin_amdgcn_rcpf(1.f + e);
}
__device__ __forceinline__ float sigm(float x) { return __builtin_amdgcn_rcpf(1.f + __builtin_amdgcn_exp2f(-1.4426950408889634f * x)); }
__device__ __forceinline__ float sq4(f32x4 v) { return v[0] * v[0] + v[1] * v[1] + v[2] * v[2] + v[3] * v[3]; }

struct RowPlain {
  const bf16_t* A; int lda;
  __device__ __forceinline__ const char* base(int kt) const { return (const char*)(A + kt * 64); }
  __device__ __forceinline__ unsigned off(int row, int kt) const { return (unsigned)row * (unsigned)(lda * 2); }
};
struct RowHalo {
  const bf16_t* A; int ko;
  __device__ __forceinline__ const char* base(int kt) const { return (const char*)(A + (kt + ko) * 64); }
  __device__ __forceinline__ unsigned off(int row, int kt) const {
    int tok = 256 * (row >> 1) - 2 + (row & 1); tok = tok < 0 ? 0 : tok;
    return (unsigned)tok * 2048u;
  }
};
struct RowSsmY {
  const bf16_t* ugg; const bf16_t* xcg;
  __device__ __forceinline__ const char* base(int kt) const { return kt < 4 ? (const char*)(ugg + kt * 64) : (const char*)(xcg + (kt - 4) * 64); }
  __device__ __forceinline__ unsigned off(int row, int kt) const { return ((unsigned)row * 512u) << (kt < 4 ? 0 : 5); }
};

__device__ __forceinline__ const char* uni_ptr(const char* p) {
  const unsigned long long u = (unsigned long long)p;
  const unsigned lo = __builtin_amdgcn_readfirstlane((unsigned)u), hi = __builtin_amdgcn_readfirstlane((unsigned)(u >> 32));
  return (const char*)(((unsigned long long)hi << 32) | lo);
}
__device__ __forceinline__ int lds_byte(int r, int c) {
  const int st = (r >> 4) * 2 + (c >> 5), ob = (r & 15) * 64 + (c & 31) * 2;
  return st * 1024 + (ob ^ (((ob >> 9) & 1) << 5));
}
__device__ __forceinline__ void stage_rc(int b, int& R, int& C) {
  const int st = b >> 10, sb = b & 1023, swz = sb ^ (((sb >> 9) & 1) << 5);
  R = (st >> 1) * 16 + swz / 64;
  C = (st & 1) * 32 + (swz % 64) / 2;
}

template <class AR>
__device__ __forceinline__ void kloop(f32x4 (&acc)[8][4], const AR& ar, const bf16_t* __restrict__ Bt, int ldb, int m0, int n0, int nt, char* smem) {
  int tid_ = threadIdx.x; asm volatile("" : "+v"(tid_));
  const int tid = tid_, wid = tid >> 6, lane = tid & 63, wr = wid >> 2, wc = wid & 3, fr = lane & 15, fq = lane >> 4;
  int sR, sC; stage_rc(wid * 1024 + lane * 16, sR, sC);
  const unsigned sC2 = (unsigned)sC * 2u;
  const unsigned bo0 = ((unsigned)(n0 + sR) * (unsigned)ldb + (unsigned)sC) * 2u;
  const size_t bstep = (size_t)ldb * 128u;
  const int ar0 = m0 + sR;
  const unsigned ldsw = __builtin_amdgcn_readfirstlane((unsigned)(size_t)smem + (unsigned)wid * 1024u);
  __syncthreads();
#define GLDS16(ldsaddr, voff, sbase) asm volatile("s_mov_b32 m0, %0\n\tglobal_load_lds_dwordx4 %1, %2" :: "s"(ldsaddr), "v"(voff), "s"(sbase) : "memory")
#define GSTAGE(buf, kt) do { const char* ab_ = uni_ptr(ar.base(kt)); const char* bb_ = uni_ptr((const char*)(Bt + (kt) * 64)); _Pragma("unroll") for (int i = 0; i < 4; ++i) { \
    GLDS16(ldsw + (unsigned)((buf) * 65536 + i * 8192), ar.off(ar0 + 64 * i, (kt)) + sC2, ab_); \
    GLDS16(ldsw + (unsigned)((buf) * 65536 + 32768 + i * 8192), bo0, bb_ + bstep * i); } } while (0)
  GSTAGE(0, 0);
  asm volatile("s_waitcnt vmcnt(0)" ::: "memory");
  __syncthreads();
#pragma unroll 1
  for (int t = 0; t < nt; ++t) {
    const int cur = t & 1;
    if (t + 1 < nt) GSTAGE(cur ^ 1, t + 1);
    const char* sA = smem + cur * 65536;
    const char* sB = sA + 32768;
#pragma unroll
    for (int ks = 0; ks < 2; ++ks) {
      bf16x8 Bf[4], At[8];
#pragma unroll
      for (int n = 0; n < 4; ++n) Bf[n] = *(const bf16x8*)(sB + lds_byte(wc * 64 + n * 16 + fr, ks * 32 + fq * 8));
#pragma unroll
      for (int m = 0; m < 8; ++m) At[m] = *(const bf16x8*)(sA + lds_byte(wr * 128 + m * 16 + fr, ks * 32 + fq * 8));
#pragma unroll
      for (int m = 0; m < 8; ++m)
#pragma unroll
        for (int n = 0; n < 4; ++n) acc[m][n] = __builtin_amdgcn_mfma_f32_16x16x32_bf16(Bf[n], At[m], acc[m][n], 0, 0, 0);
      __builtin_amdgcn_sched_group_barrier(0x100, 8, 0);
      __builtin_amdgcn_sched_group_barrier(0x008, 4, 0);
      __builtin_amdgcn_sched_group_barrier(0x100, 2, 0);
      __builtin_amdgcn_sched_group_barrier(0x008, 4, 0);
      __builtin_amdgcn_sched_group_barrier(0x100, 2, 0);
      __builtin_amdgcn_sched_group_barrier(0x008, 24, 0);
      __builtin_amdgcn_sched_barrier(0);
    }
    asm volatile("s_waitcnt vmcnt(0)" ::: "memory");
    __syncthreads();
  }
#undef GSTAGE
#undef GLDS16
}

__device__ __forceinline__ void tile_map(int L, int nM, int nN, int& pm, int& pn) {
  const int q = (nM * nN) >> 3;
  const int wgid = (L & 7) * q + (L >> 3);
  const int nig = 8 * nN, gid = wgid / nig, r = wgid - gid * nig;
  pm = gid * 8 + (r & 7); pn = r >> 3;
}
__device__ __forceinline__ void zero_acc(f32x4 (&acc)[8][4]) {
#pragma unroll
  for (int m = 0; m < 8; ++m)
#pragma unroll
    for (int n = 0; n < 4; ++n) acc[m][n] = (f32x4){0.f, 0.f, 0.f, 0.f};
}

__device__ __forceinline__ int srccol(int n, int mode) {
  if (mode == 1) { const int q64 = n >> 6, f = (n >> 4) & 3, i = n & 15; const int oc = 32 * q64 + 8 * (i >> 2) + 4 * (f >> 1) + (i & 3);
                   return (f & 1) ? 1024 + oc : oc; }
  if (mode == 2) { const int rho = n & 31, nn = rho >> 4, i = rho & 15; const int np = (n & ~31) + 8 * (i >> 2) + 4 * nn + (i & 3);
                   const int nt = np >> 8, j = np & 255; return j < 128 ? nt * 128 + j : 2816 + nt * 128 + (j - 128); }
  if (mode == 3) { const int rho = n & 31, nn = rho >> 4, i = rho & 15; return (n & ~31) + 8 * (i >> 2) + 4 * nn + (i & 3); }
  return n;
}
__device__ __forceinline__ void prep_mat(const float* __restrict__ src, int K, int N, int Nsub, bf16_t* __restrict__ dst, const float* __restrict__ gain, int mode, float* smf) {
  int tid_ = threadIdx.x; asm volatile("" : "+v"(tid_)); const int tid = tid_;
  const int KT = K >> 6, NT = Nsub >> 6, ntile = KT * NT;
  const int j = tid & 63, kq = tid >> 6;
  float v[8];
  int t = blockIdx.x;
  if (t < ntile) {
    const int k0 = (t % KT) * 64, n0 = (t / KT) * 64; const int sc = srccol(n0 + j, mode);
#pragma unroll
    for (int i = 0; i < 8; ++i) { const int k = i * 8 + kq; v[i] = src[(size_t)(k0 + k) * N + sc] * (gain ? gain[k0 + k] : 1.f); }
  }
  for (; t < ntile; t += gridDim.x) {
    const int k0 = (t % KT) * 64, n0 = (t / KT) * 64;
    __syncthreads();
#pragma unroll
    for (int i = 0; i < 8; ++i) smf[(i * 8 + kq) * 65 + j] = v[i];
    const int tn = t + gridDim.x;
    if (tn < ntile) {
      const int k1 = (tn % KT) * 64, n1 = (tn / KT) * 64; const int sc = srccol(n1 + j, mode);
#pragma unroll
      for (int i = 0; i < 8; ++i) { const int k = i * 8 + kq; v[i] = src[(size_t)(k1 + k) * N + sc] * (gain ? gain[k1 + k] : 1.f); }
    }
    __syncthreads();
    {
      const int row = tid >> 3, kv = tid & 7;
      float w[8];
#pragma unroll
      for (int e = 0; e < 8; ++e) w[e] = smf[(kv * 8 + e) * 65 + row];
      u32x4 o; o.x = pack2(w[0], w[1]); o.y = pack2(w[2], w[3]); o.z = pack2(w[4], w[5]); o.w = pack2(w[6], w[7]);
      *(u32x4*)(dst + (size_t)(n0 + row) * K + k0 + kv * 8) = o;
    }
  }
}

__device__ __forceinline__ void ssm_consts(const float* log_dt, const float* lam_re, const float* lam_im, float* ssmc, float* a16p, int L, int g, int p) {
  const float dt = expf(log_dt[L * 64 + g]);
  const float lr = lam_re[L * 4096 + g * 64 + p], li = lam_im[L * 4096 + g * 64 + p];
  const float mag = expf(lr * dt);
  const float abr = mag * cosf(li * dt), abi = mag * sinf(li * dt);
  const float den = lr * lr + li * li;
  const float fr = ((abr - 1.f) * lr + abi * li) / den;
  const float fi = (abi * lr - (abr - 1.f) * li) / den;
  *(f32x4*)(ssmc + (size_t)((L * 64 + g) * 64 + p) * 4) = (f32x4){abr, abi, fr, fi};
  float xr = abr, xi = abi;
#pragma unroll
  for (int q = 0; q < 4; ++q) { float nr = xr * xr - xi * xi, ni = 2.f * xr * xi; xr = nr; xi = ni; }
  a16p[(size_t)L * 8192 + (g * 64 + p) * 2] = xr; a16p[(size_t)L * 8192 + (g * 64 + p) * 2 + 1] = xi;
}

__device__ __forceinline__ void prep_ssm(const float* ssmcL, const float* b_re, const float* b_im,
                         const float* c_re, const float* c_im, bf16_t* PT, bf16_t* YT, float* smf) {
  int tid_ = threadIdx.x; asm volatile("" : "+v"(tid_)); const int tid = tid_;
  float* s_abr = smf; float* s_abi = smf + 64; float* s_fr = smf + 128; float* s_fi = smf + 192;
  float* s_pr = smf + 256; float* s_pi = smf + 320;
  for (int g = blockIdx.x; g < 64; g += gridDim.x) {
    __syncthreads();
    if (tid < 64) {
      const f32x4 cc = *(const f32x4*)(ssmcL + (size_t)(g * 64 + tid) * 4);
      s_abr[tid] = cc[0]; s_abi[tid] = cc[1]; s_fr[tid] = cc[2]; s_fi[tid] = cc[3];
      s_pr[tid] = 1.f; s_pi[tid] = 0.f;
    }
    __syncthreads();
    if (tid < 256) {
      const int co = tid >> 4, ci = tid & 15;
      bf16_t* yg = YT + (size_t)g * 256 * 384;
      float kj[16];
#pragma unroll
      for (int j = 0; j < 16; ++j) kj[j] = 0.f;
#pragma unroll 2
      for (int p = 0; p < 64; ++p) {
        const float br = b_re[(g * 64 + p) * 16 + ci], bi = b_im[(g * 64 + p) * 16 + ci];
        const float fr = s_fr[p], fi = s_fi[p], ar = s_abr[p], ai = s_abi[p];
        const float bbr = fr * br - fi * bi, bbi = fr * bi + fi * br;
        const float cr = c_re[(g * 16 + co) * 64 + p], cim = c_im[(g * 16 + co) * 64 + p];
        float zr = cr * bbr - cim * bbi, zi = cr * bbi + cim * bbr;
#pragma unroll
        for (int j = 0; j < 16; ++j) { kj[j] += zr; const float nr = zr * ar - zi * ai, ni = zr * ai + zi * ar; zr = nr; zi = ni; }
      }
#pragma unroll
      for (int j = 0; j < 16; ++j) {
        const bf16_t v = f2bf(kj[j]);
#pragma unroll 1
        for (int t = j; t < 16; ++t) yg[(t * 16 + co) * 384 + (t - j) * 16 + ci] = v;
        if (j > 0) {
#pragma unroll 1
          for (int t = 0; t + j < 16; ++t) yg[(t * 16 + co) * 384 + (t + j) * 16 + ci] = 0;
        }
      }
    }
    {
      bf16_t* yg = YT + (size_t)g * 256 * 384;
#pragma unroll 1
      for (int i = 0; i < 2; ++i) {
        const int idx = tid + 512 * i, co = idx >> 6, p = idx & 63;
        const float ar = s_abr[p], ai = s_abi[p];
        float zr = c_re[(g * 16 + co) * 64 + p], zi = c_im[(g * 16 + co) * 64 + p];
#pragma unroll 1
        for (int t = 0; t < 16; ++t) {
          const float nr = zr * ar - zi * ai, ni = zr * ai + zi * ar; zr = nr; zi = ni;
          yg[(t * 16 + co) * 384 + 256 + p] = f2bf(zr);
          yg[(t * 16 + co) * 384 + 320 + p] = f2bf(-zi);
        }
      }
    }
    {
      bf16_t* pg = PT + (size_t)g * 128 * 256;
#pragma unroll 1
      for (int i = 0; i < 2; ++i) {
        const int idx = tid + 512 * i, p = idx >> 4, c = idx & 15;
        const float ar = s_abr[p], ai = s_abi[p], fr = s_fr[p], fi = s_fi[p];
        const float br = b_re[(g * 64 + p) * 16 + c], bi = b_im[(g * 64 + p) * 16 + c];
        float zr = fr * br - fi * bi, zi = fr * bi + fi * br;
#pragma unroll 1
        for (int t = 15; t >= 0; --t) {
          pg[p * 256 + t * 16 + c] = f2bf(zr);
          pg[(64 + p) * 256 + t * 16 + c] = f2bf(zi);
          const float nr = zr * ar - zi * ai, ni = zr * ai + zi * ar; zr = nr; zi = ni;
        }
      }
    }
  }
}

__device__ __forceinline__ void prep_bias(const float* rel_bias, float* tab) {
  if (blockIdx.x == 0) {
    int tid_ = threadIdx.x; asm volatile("" : "+v"(tid_));
    for (int idx = tid_; idx < 8 * 129; idx += NTHR) {
      const int h = idx / 129, n = idx % 129;
      int bucket;
      if (n < 16) bucket = n;
      else {
        bucket = 16 + (n >= 19) + (n >= 21) + (n >= 24) + (n >= 27) + (n >= 31) + (n >= 35) + (n >= 40) + (n >= 46) + (n >= 52) + (n >= 59)
                 + (n >= 67) + (n >= 77) + (n >= 87) + (n >= 99) + (n >= 113);
      }
      tab[h * 132 + n] = rel_bias[bucket * 8 + h] * 1.4426950408889634f;
    }
    if (tid_ < 8) {
      float mx = -1e30f;
      for (int bk = 0; bk < 32; ++bk) mx = fmaxf(mx, rel_bias[bk * 8 + tid_] * 1.4426950408889634f);
      tab[tid_ * 132 + 129] = mx;
    }
  }
}

__device__ __forceinline__ void prep_x(const float* xin, bf16_t* xbuf, rss_t* rowss) {
  int tid_ = threadIdx.x; asm volatile("" : "+v"(tid_)); const int tid = tid_, wid = tid >> 6, lane = tid & 63;
  for (int i = blockIdx.x * NTHR + tid; i < 12 * 32768; i += gridDim.x * NTHR) rowss[32768 + i] = 0ull;
#pragma unroll 2
  for (int row = blockIdx.x * 8 + wid; row < 32768; row += gridDim.x * 8) {
    float ss = 0.f;
#pragma unroll
    for (int i = 0; i < 2; ++i) {
      const f32x4* p = (const f32x4*)(xin + (size_t)row * 1024 + i * 512 + lane * 8);
      const f32x4 a = p[0], b = p[1];
      u32x4 o; o.x = pack2(a[0], a[1]); o.y = pack2(a[2], a[3]); o.z = pack2(b[0], b[1]); o.w = pack2(b[2], b[3]);
      *(u32x4*)(xbuf + (size_t)row * 1024 + i * 512 + lane * 8) = o;
      ss += sq4(a) + sq4(b);
    }
#pragma unroll
    for (int o = 32; o >= 1; o >>= 1) ss += __shfl_xor(ss, o);
    if (lane == 0) rowss[row] = (rss_t)(ss * RSS_SCALE + 0.5f);
  }
}
__device__ __forceinline__ void prep_p(const float* pin, bf16_t* pbf) {
  int tid_ = threadIdx.x; asm volatile("" : "+v"(tid_));
#pragma unroll 4
  for (size_t i = (size_t)blockIdx.x * NTHR + tid_; i < (size_t)32768 * 256 / 8; i += (size_t)gridDim.x * NTHR) {
    const f32x4* p = (const f32x4*)(pin + i * 8);
    const f32x4 a = p[0], b = p[1];
    u32x4 o; o.x = pack2(a[0], a[1]); o.y = pack2(a[2], a[3]); o.z = pack2(b[0], b[1]); o.w = pack2(b[2], b[3]);
    *(u32x4*)(pbf + i * 8) = o;
  }
}

#define ROWL(m) (wr * 128 + (m) * 16 + lr)
#define COLL(n) (wc * 64 + (n) * 16 + lq * 4)
#define COLP(p) (wc * 64 + (p) * 32 + lq * 8)
#define LANE_IDS int tid_ = threadIdx.x; asm volatile("" : "+v"(tid_)); const int tid = tid_, lane = tid & 63, wid = tid >> 6, wr = wid >> 2, wc = wid & 3; (void)tid; (void)lane; (void)wr; (void)wc;
#define EPI_IDS int lq = lane >> 4, lr = lane & 15; asm volatile("" : "+v"(lq), "+v"(lr));
#define RSTD(rs, row) rsqrtf((float)(rs)[row] * (1.f / (1024.f * RSS_SCALE)) + EPSF)
#define RSS_ADD(p, v) atomicAdd((p), (rss_t)((v) * RSS_SCALE + 0.5f))

__device__ __forceinline__ void ph_win(const bf16_t* xbp, const rss_t* rs, const bf16_t* Wt, bf16_t* ugp, char* smem) {
  LANE_IDS
  RowPlain ar{xbp, 1024};
  for (int t = blockIdx.x; t < 128 * 4; t += gridDim.x) {
    int mt, nt; tile_map(t, 128, 4, mt, nt); const int m0 = mt * 256, n0 = nt * 256;
    f32x4 acc[8][4]; zero_acc(acc);
    kloop(acc, ar, Wt, 1024, m0, n0, 16, smem);
    EPI_IDS
#pragma unroll
    for (int m = 0; m < 8; ++m) {
      const int tok = m0 + ROWL(m);
      const float rstd = RSTD(rs, tok);
#pragma unroll
      for (int p = 0; p < 2; ++p) {
        const int c0 = n0 + COLP(p), g = c0 >> 4;
        const f32x4 v0 = acc[m][2 * p] * rstd, v1 = acc[m][2 * p + 1] * rstd;
        u32x4 o; o.x = pack2(v0[0], v0[1]); o.y = pack2(v0[2], v0[3]); o.z = pack2(v1[0], v1[1]); o.w = pack2(v1[2], v1[3]);
        *(u32x4*)(ugp + ((size_t)(g * 2048 + (tok >> 4)) * 256 + (tok & 15) * 16 + (c0 & 15))) = o;
      }
    }
  }
}

__device__ __forceinline__ void ph_sstate(const bf16_t* ugp, const bf16_t* PTp, float* S, char* smem) {
  LANE_IDS
  for (int t = blockIdx.x; t < 64 * 8; t += gridDim.x) {
    const int g = t >> 3, mt = t & 7, m0 = mt * 256;
    RowPlain ar{ugp + (size_t)g * 2048 * 256, 256};
    f32x4 acc[8][4]; zero_acc(acc);
    kloop(acc, ar, PTp + (size_t)g * 128 * 256, 256, m0, 0, 4, smem);
    EPI_IDS
    if (wc < 2) {
#pragma unroll
      for (int m = 0; m < 8; ++m) {
        const int row = m0 + ROWL(m);
#pragma unroll
        for (int n = 0; n < 4; ++n) *(f32x4*)(S + ((size_t)row * 64 + g) * 128 + COLL(n)) = acc[m][n];
      }
    }
  }
}

__device__ __forceinline__ void ph_scan(const float* S, const float* a16p, bf16_t* Xcp) {
  int tid_ = threadIdx.x; asm volatile("" : "+v"(tid_));
  for (int idx = blockIdx.x * NTHR + tid_; idx < 16 * 64 * 64; idx += gridDim.x * NTHR) {
    const int p = idx & 63, g = (idx >> 6) & 63, b = idx >> 12;
    const float ar = a16p[(g * 64 + p) * 2], ai = a16p[(g * 64 + p) * 2 + 1];
    float xr = 0.f, xi = 0.f;
#pragma unroll 8
    for (int c = 0; c < 128; ++c) {
      const size_t off = ((size_t)(b * 128 + c) * 64 + g) * 128;
      Xcp[off + p] = f2bf(xr); Xcp[off + 64 + p] = f2bf(xi);
      const float sr = S[off + p], si = S[off + 64 + p];
      const float nr = ar * xr - ai * xi + sr, ni = ar * xi + ai * xr + si;
      xr = nr; xi = ni;
    }
  }
}

__device__ __forceinline__ void ph_ssmy(const bf16_t* ugp, const bf16_t* Xcp, const bf16_t* YTp, const float* dskip, bf16_t* gyp, char* smem) {
  LANE_IDS
  for (int t = blockIdx.x; t < 64 * 8; t += gridDim.x) {
    const int g = t >> 3, mt = t & 7, m0 = mt * 256;
    const bf16_t* ugg = ugp + (size_t)g * 2048 * 256;
    RowSsmY ar{ugg, Xcp + (size_t)g * 128};
    f32x4 acc[8][4]; zero_acc(acc);
    kloop(acc, ar, YTp + (size_t)g * 256 * 384, 384, m0, 0, 6, smem);
    EPI_IDS
    const f32x4 dv = *(const f32x4*)(dskip + g * 16 + lq * 4);
#pragma unroll
    for (int m = 0; m < 8; ++m) {
      asm volatile("" ::: "memory");
      const int row = m0 + ROWL(m);
#pragma unroll
      for (int n = 0; n < 4; ++n) {
        const int tt = wc * 4 + n;
        const u32x2 uu = *(const u32x2*)(ugg + (size_t)row * 256 + tt * 16 + lq * 4);
        f32x4 y = acc[m][n];
        y[0] += dv[0] * bflo(uu.x); y[1] += dv[1] * bfhi(uu.x); y[2] += dv[2] * bflo(uu.y); y[3] += dv[3] * bfhi(uu.y);
        u32x2 o; o.x = pack2(gelu_t(y[0]), gelu_t(y[1])); o.y = pack2(gelu_t(y[2]), gelu_t(y[3]));
        *(u32x2*)(gyp + (size_t)(row * 16 + tt) * 1024 + g * 16 + lq * 4) = o;
      }
    }
  }
}

__device__ __forceinline__ void ph_ssm_fused(const bf16_t* ugp, const bf16_t* PTp, const bf16_t* YTp, const float* a16p, bf16_t* Xcp,
                                             const float* dskip, bf16_t* gyp, char* smem) {
  LANE_IDS
  float* Sl = (float*)smem;
  for (int t = blockIdx.x; t < 64 * 8; t += gridDim.x) {
    const int g = t >> 3, mt = t & 7, m0 = mt * 256;
    const bf16_t* ugg = ugp + (size_t)g * 2048 * 256;
    {
      RowPlain ar{ugg, 256};
      f32x4 acc[8][4]; zero_acc(acc);
      kloop(acc, ar, PTp + (size_t)g * 128 * 256, 256, m0, 0, 4, smem);
      EPI_IDS
      if (wc < 2) {
#pragma unroll
        for (int m = 0; m < 8; ++m)
#pragma unroll
          for (int n = 0; n < 4; ++n) *(f32x4*)(Sl + ROWL(m) * 128 + COLL(n)) = acc[m][n];
      }
    }
    __syncthreads();
    if (tid < 128) {
      const int bb = tid >> 6, p = tid & 63;
      const float ar_ = a16p[(g * 64 + p) * 2], ai_ = a16p[(g * 64 + p) * 2 + 1];
      float xr = 0.f, xi = 0.f;
      bf16_t* xo = Xcp + ((size_t)(m0 + bb * 128) * 64 + g) * 128;
      const float* sl = Sl + (bb * 128) * 128;
#pragma unroll 8
      for (int c = 0; c < 128; ++c) {
        xo[(size_t)c * 8192 + p] = f2bf(xr); xo[(size_t)c * 8192 + 64 + p] = f2bf(xi);
        const float sr = sl[c * 128 + p], si = sl[c * 128 + 64 + p];
        const float nr = ar_ * xr - ai_ * xi + sr, ni = ar_ * xi + ai_ * xr + si;
        xr = nr; xi = ni;
      }
    }
    __builtin_amdgcn_fence(__ATOMIC_RELEASE, "workgroup");
    asm volatile("s_waitcnt vmcnt(0)" ::: "memory");
    __syncthreads();
    {
      RowSsmY ar{ugg, Xcp + (size_t)g * 128};
      f32x4 acc[8][4]; zero_acc(acc);
      kloop(acc, ar, YTp + (size_t)g * 256 * 384, 384, m0, 0, 6, smem);
      EPI_IDS
      const f32x4 dv = *(const f32x4*)(dskip + g * 16 + lq * 4);
#pragma unroll
      for (int m = 0; m < 8; ++m) {
        asm volatile("" ::: "memory");
        const int row = m0 + ROWL(m);
#pragma unroll
        for (int n = 0; n < 4; ++n) {
          const int tt = wc * 4 + n;
          const u32x2 uu = *(const u32x2*)(ugg + (size_t)row * 256 + tt * 16 + lq * 4);
          f32x4 y = acc[m][n];
          y[0] += dv[0] * bflo(uu.x); y[1] += dv[1] * bfhi(uu.x); y[2] += dv[2] * bflo(uu.y); y[3] += dv[3] * bfhi(uu.y);
          u32x2 o; o.x = pack2(gelu_t(y[0]), gelu_t(y[1])); o.y = pack2(gelu_t(y[2]), gelu_t(y[3]));
          *(u32x2*)(gyp + (size_t)(row * 16 + tt) * 1024 + g * 16 + lq * 4) = o;
        }
      }
    }
  }
}

__device__ __forceinline__ void ph_wglu(const bf16_t* gyp, const bf16_t* Wt, bf16_t* xbp, rss_t* rso, char* smem) {
  LANE_IDS
  RowPlain ar{gyp, 1024};
  for (int t = blockIdx.x; t < 128 * 8; t += gridDim.x) {
    int mt, nt; tile_map(t, 128, 8, mt, nt); const int m0 = mt * 256, n0 = nt * 256;
    f32x4 acc[8][4]; zero_acc(acc);
    kloop(acc, ar, Wt, 1024, m0, n0, 16, smem);
    EPI_IDS
    const int oc = ((n0 + wc * 64) >> 1) + lq * 8;
    u32x4 xq[2];
#pragma unroll
    for (int m = 0; m < 2; ++m) xq[m] = *(const u32x4*)(xbp + (size_t)(m0 + ROWL(m)) * 1024 + oc);
#pragma unroll
    for (int m = 0; m < 8; ++m) {
      const int row = m0 + ROWL(m);
      const size_t rowoff = (size_t)row * 1024;
      asm volatile("" ::: "memory");
      const u32x4 xr = xq[m & 1];
      f32x4 xa = (f32x4){bflo(xr.x), bfhi(xr.x), bflo(xr.y), bfhi(xr.y)}, xc = (f32x4){bflo(xr.z), bfhi(xr.z), bflo(xr.w), bfhi(xr.w)};
#pragma unroll
      for (int r = 0; r < 4; ++r) { xa[r] += acc[m][0][r] * sigm(acc[m][1][r]); xc[r] += acc[m][2][r] * sigm(acc[m][3][r]); }
      u32x4 o; o.x = pack2(xa[0], xa[1]); o.y = pack2(xa[2], xa[3]); o.z = pack2(xc[0], xc[1]); o.w = pack2(xc[2], xc[3]);
      *(u32x4*)(xbp + rowoff + oc) = o;
      float ss = sq4(xa) + sq4(xc);
      if (m + 2 < 8) xq[m & 1] = *(const u32x4*)(xbp + (size_t)(m0 + ROWL(m + 2)) * 1024 + oc);
      ss += __shfl_xor(ss, 16); ss += __shfl_xor(ss, 32);
      if (lq == 0) RSS_ADD(rso + row, ss);
    }
  }
}

__device__ __forceinline__ void ph_resid(const bf16_t* A, int K, const bf16_t* Bt, bf16_t* xbp, rss_t* rso, char* smem) {
  LANE_IDS
  RowPlain ar{A, K};
  for (int t = blockIdx.x; t < 128 * 4; t += gridDim.x) {
    int mt, nt; tile_map(t, 128, 4, mt, nt); const int m0 = mt * 256, n0 = nt * 256;
    f32x4 acc[8][4]; zero_acc(acc);
    kloop(acc, ar, Bt, K, m0, n0, K >> 6, smem);
    EPI_IDS
    u32x4 xq[2][2];
#pragma unroll
    for (int m = 0; m < 2; ++m)
#pragma unroll
      for (int p = 0; p < 2; ++p) xq[m][p] = *(const u32x4*)(xbp + (size_t)(m0 + ROWL(m)) * 1024 + n0 + COLP(p));
#pragma unroll
    for (int m = 0; m < 8; ++m) {
      const int row = m0 + ROWL(m);
      const size_t rowoff = (size_t)row * 1024;
      float ss = 0.f;
      asm volatile("" ::: "memory");
#pragma unroll
      for (int p = 0; p < 2; ++p) {
        const int oc = n0 + COLP(p);
        const u32x4 xr = xq[m & 1][p];
        f32x4 xa = acc[m][2 * p], xc = acc[m][2 * p + 1];
        xa[0] += bflo(xr.x); xa[1] += bfhi(xr.x); xa[2] += bflo(xr.y); xa[3] += bfhi(xr.y);
        xc[0] += bflo(xr.z); xc[1] += bfhi(xr.z); xc[2] += bflo(xr.w); xc[3] += bfhi(xr.w);
        u32x4 o; o.x = pack2(xa[0], xa[1]); o.y = pack2(xa[2], xa[3]); o.z = pack2(xc[0], xc[1]); o.w = pack2(xc[2], xc[3]);
        *(u32x4*)(xbp + rowoff + oc) = o;
        ss += sq4(xa) + sq4(xc);
      }
      if (m + 2 < 8) {
#pragma unroll
        for (int p = 0; p < 2; ++p) xq[m & 1][p] = *(const u32x4*)(xbp + (size_t)(m0 + ROWL(m + 2)) * 1024 + n0 + COLP(p));
      }
      ss += __shfl_xor(ss, 16); ss += __shfl_xor(ss, 32);
      if (lq == 0) RSS_ADD(rso + row, ss);
    }
  }
}

__device__ __forceinline__ void ph_halo_proj(const bf16_t* xbp, const rss_t* rs, const bf16_t* WupTp, float* halop, const bf16_t* pbf, const bf16_t* WpjTp, bf16_t* pj, char* smem) {
  LANE_IDS
  for (int t = blockIdx.x; t < 44; t += gridDim.x) {
    f32x4 acc[8][4]; zero_acc(acc);
    const int nt = t >> 1, kh = t & 1, m0 = 0, n0 = nt * 256;
    RowHalo ar{xbp, kh * 8};
    kloop(acc, ar, WupTp + kh * 512, 1024, m0, n0, 8, smem);
    EPI_IDS
#pragma unroll
    for (int m = 0; m < 8; ++m) {
      const int r = m0 + ROWL(m);
      int tok = 256 * (r >> 1) - 2 + (r & 1); tok = tok < 0 ? 0 : tok;
      const float rstd = RSTD(rs, tok);
#pragma unroll
      for (int n = 0; n < 4; ++n) *(f32x4*)(halop + (size_t)kh * 256 * 5632 + (size_t)r * 5632 + n0 + COLP(n >> 1) + (n & 1) * 4) = acc[m][n] * rstd;
    }
  }
}
__device__ __forceinline__ void ph_proj(const bf16_t* pbf, const bf16_t* WpjTp, bf16_t* pj, char* smem) {
  LANE_IDS
  for (int t = gridDim.x - 1 - blockIdx.x; t < 512; t += gridDim.x) {
    f32x4 acc[8][4]; zero_acc(acc);
    int mt, nt; tile_map(t, 128, 4, mt, nt); const int m0 = mt * 256, n0 = nt * 256;
    RowPlain ar{pbf, 256};
    kloop(acc, ar, WpjTp, 256, m0, n0, 4, smem);
    EPI_IDS
#pragma unroll
    for (int m = 0; m < 8; ++m) {
      const size_t rowoff = (size_t)(m0 + ROWL(m)) * 1024;
#pragma unroll
      for (int p = 0; p < 2; ++p) {
        const f32x4 a0 = acc[m][2 * p], a1 = acc[m][2 * p + 1];
        u32x4 o; o.x = pack2(a0[0], a0[1]); o.y = pack2(a0[2], a0[3]); o.z = pack2(a1[0], a1[1]); o.w = pack2(a1[2], a1[3]);
        *(u32x4*)(pj + rowoff + n0 + COLP(p)) = o;
      }
    }
  }
}

__device__ __forceinline__ void ph_up(const bf16_t* xbp, const rss_t* rs, const bf16_t* WupTp, const float* halop, const float* convw, const float* convb, bf16_t* actp, char* smem) {
  LANE_IDS
  RowPlain ar{xbp, 1024};
  bf16_t* st = (bf16_t*)(smem + 1024);
  for (int t = blockIdx.x; t < 128 * 22; t += gridDim.x) {
    int mt, nt; tile_map(t, 128, 22, mt, nt); const int m0 = mt * 256, n0 = nt * 256;
    f32x4 acc[8][4]; zero_acc(acc);
    kloop(acc, ar, WupTp, 1024, m0, n0, 16, smem);
    EPI_IDS
#pragma unroll
    for (int m = 0; m < 8; ++m) {
      const float rstd = RSTD(rs, m0 + ROWL(m));
#pragma unroll
      for (int p = 0; p < 2; ++p) {
        const f32x4 v0 = acc[m][2 * p] * rstd, v1 = acc[m][2 * p + 1] * rstd;
        u32x4 o; o.x = pack2(v0[0], v0[1]); o.y = pack2(v0[2], v0[3]); o.z = pack2(v1[0], v1[1]); o.w = pack2(v1[2], v1[3]);
        *(u32x4*)(st + (2 + ROWL(m)) * 256 + COLP(p)) = o;
      }
    }
    {
      const int j = tid >> 8, col = tid & 255;
      float hv = 0.f;
      if ((m0 & 2047) != 0) hv = halop[(size_t)(2 * mt + j) * 5632 + n0 + col] + halop[(size_t)256 * 5632 + (size_t)(2 * mt + j) * 5632 + n0 + col];
      st[j * 256 + col] = f2bf(hv);
    }
    __syncthreads();
    {
      const int cp = tid & 31, rg = tid >> 5;
      const int hc = nt * 128 + 4 * cp;
      float wg[3][4], wv[3][4], bg[4], bv[4];
#pragma unroll
      for (int j = 0; j < 3; ++j) {
        const f32x4 a = *(const f32x4*)(convw + j * 5632 + hc), c = *(const f32x4*)(convw + j * 5632 + 2816 + hc);
#pragma unroll
        for (int e = 0; e < 4; ++e) { wg[j][e] = a[e]; wv[j][e] = c[e]; }
      }
      {
        const f32x4 a = *(const f32x4*)(convb + hc), c = *(const f32x4*)(convb + 2816 + hc);
#pragma unroll
        for (int e = 0; e < 4; ++e) { bg[e] = a[e]; bv[e] = c[e]; }
      }
      const int r0 = rg * 16;
      u32x2 g2 = *(const u32x2*)(st + (r0) * 256 + 4 * cp), v2 = *(const u32x2*)(st + (r0) * 256 + 128 + 4 * cp);
      u32x2 g1 = *(const u32x2*)(st + (r0 + 1) * 256 + 4 * cp), v1 = *(const u32x2*)(st + (r0 + 1) * 256 + 128 + 4 * cp);
#pragma unroll 4
      for (int r = 0; r < 16; ++r) {
        const u32x2 g0 = *(const u32x2*)(st + (r0 + r + 2) * 256 + 4 * cp), v0 = *(const u32x2*)(st + (r0 + r + 2) * 256 + 128 + 4 * cp);
        float o4[4];
#pragma unroll
        for (int e = 0; e < 4; ++e) {
          const uint32_t wg2 = (e < 2) ? g2.x : g2.y, wg1 = (e < 2) ? g1.x : g1.y, wg0 = (e < 2) ? g0.x : g0.y;
          const uint32_t wv2 = (e < 2) ? v2.x : v2.y, wv1 = (e < 2) ? v1.x : v1.y, wv0 = (e < 2) ? v0.x : v0.y;
          const float a2 = (e & 1) ? bfhi(wg2) : bflo(wg2), a1 = (e & 1) ? bfhi(wg1) : bflo(wg1), a0 = (e & 1) ? bfhi(wg0) : bflo(wg0);
          const float c2 = (e & 1) ? bfhi(wv2) : bflo(wv2), c1 = (e & 1) ? bfhi(wv1) : bflo(wv1), c0 = (e & 1) ? bfhi(wv0) : bflo(wv0);
          const float cg = bg[e] + wg[0][e] * a2 + wg[1][e] * a1 + wg[2][e] * a0;
          const float cv = bv[e] + wv[0][e] * c2 + wv[1][e] * c1 + wv[2][e] * c0;
          o4[e] = gelu_t(cg) * cv;
        }
        u32x2 o; o.x = pack2(o4[0], o4[1]); o.y = pack2(o4[2], o4[3]);
        *(u32x2*)(actp + (size_t)(m0 + r0 + r) * 2816 + hc) = o;
        g2 = g1; g1 = g0; v2 = v1; v1 = v0;
      }
    }
  }
}

__device__ __forceinline__ void ph_ple(const bf16_t* xbp, const rss_t* rs, const bf16_t* WgtTp, float* xout, bf16_t* xnx, rss_t* rso, bool last, char* smem) {
  LANE_IDS
  RowPlain ar{xbp, 1024};
  for (int t = blockIdx.x; t < 128 * 4; t += gridDim.x) {
    int mt, nt; tile_map(t, 128, 4, mt, nt); const int m0 = mt * 256, n0 = nt * 256;
    f32x4 acc[8][4]; zero_acc(acc);
    kloop(acc, ar, WgtTp, 1024, m0, n0, 16, smem);
    EPI_IDS
    u32x4 xq[2][2], pq[2][2]; float rq[2];
#pragma unroll
    for (int m = 0; m < 2; ++m) {
      rq[m] = RSTD(rs, m0 + ROWL(m));
#pragma unroll
      for (int p = 0; p < 2; ++p) {
        xq[m][p] = *(const u32x4*)(xbp + (size_t)(m0 + ROWL(m)) * 1024 + n0 + COLP(p));
        pq[m][p] = *(const u32x4*)(xnx + (size_t)(m0 + ROWL(m)) * 1024 + n0 + COLP(p));
      }
    }
#pragma unroll
    for (int m = 0; m < 8; ++m) {
      const int row = m0 + ROWL(m);
      const size_t rowoff = (size_t)row * 1024;
      float ss = 0.f;
      asm volatile("" ::: "memory");
      const float rstd = rq[m & 1];
#pragma unroll
      for (int p = 0; p < 2; ++p) {
        const int oc = n0 + COLP(p);
        const u32x4 xr = xq[m & 1][p];
        const u32x4 pp = pq[m & 1][p];
        const f32x4 g0 = acc[m][2 * p], g1 = acc[m][2 * p + 1];
        f32x4 xa, xc;
        xa[0] = bflo(xr.x) + sigm(g0[0] * rstd) * bflo(pp.x);
        xa[1] = bfhi(xr.x) + sigm(g0[1] * rstd) * bfhi(pp.x);
        xa[2] = bflo(xr.y) + sigm(g0[2] * rstd) * bflo(pp.y);
        xa[3] = bfhi(xr.y) + sigm(g0[3] * rstd) * bfhi(pp.y);
        xc[0] = bflo(xr.z) + sigm(g1[0] * rstd) * bflo(pp.z);
        xc[1] = bfhi(xr.z) + sigm(g1[1] * rstd) * bfhi(pp.z);
        xc[2] = bflo(xr.w) + sigm(g1[2] * rstd) * bflo(pp.w);
        xc[3] = bfhi(xr.w) + sigm(g1[3] * rstd) * bfhi(pp.w);
        if (last) { *(f32x4*)(xout + rowoff + oc) = xa; *(f32x4*)(xout + rowoff + oc + 4) = xc; }
        else {
          u32x4 o; o.x = pack2(xa[0], xa[1]); o.y = pack2(xa[2], xa[3]); o.z = pack2(xc[0], xc[1]); o.w = pack2(xc[2], xc[3]);
          *(u32x4*)(xnx + rowoff + oc) = o;
          ss += sq4(xa) + sq4(xc);
        }
      }
      if (m + 2 < 8) {
        rq[m & 1] = RSTD(rs, m0 + ROWL(m + 2));
#pragma unroll
        for (int p = 0; p < 2; ++p) {
          xq[m & 1][p] = *(const u32x4*)(xbp + (size_t)(m0 + ROWL(m + 2)) * 1024 + n0 + COLP(p));
          pq[m & 1][p] = *(const u32x4*)(xnx + (size_t)(m0 + ROWL(m + 2)) * 1024 + n0 + COLP(p));
        }
      }
      if (!last) {
        ss += __shfl_xor(ss, 16); ss += __shfl_xor(ss, 32);
        if (lq == 0) RSS_ADD(rso + row, ss);
      }
    }
  }
}

__device__ __forceinline__ void ph_kvq(const bf16_t* xbp, const rss_t* rs, const bf16_t* Wt, int NT, int coloff, const float* knorm, const float* qnorm,
                       bf16_t* Kbp, bf16_t* Vtp, bf16_t* Qbp, char* smem) {
  LANE_IDS
  RowPlain ar{xbp, 1024};
  const float qscale = 0.125f * 1.4426950408889634f;
  for (int t = blockIdx.x; t < 128 * NT; t += gridDim.x) {
    int mt, nt; tile_map(t, 128, NT, mt, nt); const int m0 = mt * 256, n0 = nt * 256;
    f32x4 acc[8][4]; zero_acc(acc);
    kloop(acc, ar, Wt, 1024, m0, n0, 16, smem);
    EPI_IDS
    const int cw = coloff + n0 + wc * 64;
#pragma unroll
    for (int m = 0; m < 8; ++m) {
      const int tok = m0 + ROWL(m);
      const float rstd = RSTD(rs, tok);
      f32x4 v[4];
      float ss = 0.f;
#pragma unroll
      for (int n = 0; n < 4; ++n) { v[n] = acc[m][n] * rstd; ss += sq4(v[n]); }
      if (cw >= 1024 && cw < 2048) {
        const int b = tok >> 11, tt = tok & 2047;
#pragma unroll
        for (int n = 0; n < 4; ++n)
#pragma unroll
          for (int r = 0; r < 4; ++r) {
            const int j = cw - 1024 + (n >> 1) * 32 + lq * 8 + (n & 1) * 4 + r;
            Vtp[((size_t)(b * 1024 + j)) * 2048 + tt] = f2bf(v[n][r]);
          }
      } else {
        ss += __shfl_xor(ss, 16); ss += __shfl_xor(ss, 32);
        const bool isq = cw >= 2048;
        const float hn = rsqrtf(ss * (1.f / 64.f) + EPSF) * (isq ? qscale : 1.f);
        const float* gn = isq ? qnorm : knorm;
        bf16_t* dst = isq ? (Qbp + (size_t)tok * 1024 + (cw - 2048)) : (Kbp + (size_t)tok * 1024 + cw);
#pragma unroll
        for (int p = 0; p < 2; ++p) {
          const int d0 = p * 32 + lq * 8;
          const f32x4 g0 = *(const f32x4*)(gn + d0), g1 = *(const f32x4*)(gn + d0 + 4);
          const f32x4 a0 = v[2 * p] * hn * g0, a1 = v[2 * p + 1] * hn * g1;
          u32x4 o; o.x = pack2(a0[0], a0[1]); o.y = pack2(a0[2], a0[3]); o.z = pack2(a1[0], a1[1]); o.w = pack2(a1[2], a1[3]);
          *(u32x4*)(dst + d0) = o;
        }
      }
    }
  }
}

#define ATT_COMPUTE(KT_, KST_) do { \
_Pragma("unroll 1") \
      for (int hf = 0; hf < 2; ++hf) { \
        const int key0 = (KT_) * 64 + hf * 32; \
        if (key0 > q0 + wid * 16 + 15) break;     \
        const char* Ks = KST_ + hf * 32 * 272; \
        const char* Vs = KST_ + 17408 + hf * 64; \
        const bool far = (q0 + wid * 16 - (key0 + 31)) >= 128;       \
        const bool diag = key0 + 31 > q0 + wid * 16;                 \
        float bias[2][4]; \
        if (!far) { \
_Pragma("unroll") \
          for (int nf = 0; nf < 2; ++nf) \
_Pragma("unroll") \
            for (int r = 0; r < 4; ++r) { \
              const int dist = qpos - (key0 + lq * 8 + nf * 4 + r); \
              const int idx = dist < 0 ? 0 : (dist > 128 ? 128 : dist); \
              bias[nf][r] = (diag && dist < 0) ? -1e30f : tab[idx]; \
            } \
        } else { \
_Pragma("unroll") \
          for (int nf = 0; nf < 2; ++nf) \
_Pragma("unroll") \
            for (int r = 0; r < 4; ++r) bias[nf][r] = bfar; \
        } \
          \
        __builtin_amdgcn_sched_barrier(0);     \
        bf16x8 kfa[2][2], kfb[2][2]; \
_Pragma("unroll") \
        for (int nf = 0; nf < 2; ++nf) \
_Pragma("unroll") \
          for (int ks = 0; ks < 2; ++ks) \
            kfa[nf][ks] = *(const bf16x8*)(Ks + (8 * (lr >> 2) + 4 * nf + (lr & 3)) * 272 + (ks * 32 + lq * 8) * 2);     \
        __builtin_amdgcn_sched_barrier(0);     \
        f32x4 sa[2], sb[2]; \
_Pragma("unroll") \
        for (int nf = 0; nf < 2; ++nf) { \
          f32x4 a = (f32x4){bias[nf][0] - mb[0], bias[nf][1] - mb[0], bias[nf][2] - mb[0], bias[nf][3] - mb[0]};     \
_Pragma("unroll") \
          for (int ks = 0; ks < 2; ++ks) a = __builtin_amdgcn_mfma_f32_16x16x32_bf16(kfa[nf][ks], qf[0][ks], a, 0, 0, 0); \
          sa[nf] = a; \
_Pragma("unroll") \
          for (int ks = 0; ks < 2; ++ks) \
            kfb[nf][ks] = *(const bf16x8*)(Ks + (8 * (lr >> 2) + 4 * nf + (lr & 3)) * 272 + (64 + ks * 32 + lq * 8) * 2); \
        } \
        __builtin_amdgcn_sched_barrier(0);     \
        bf16x8 vfa[4], vfb[4]; \
_Pragma("unroll") \
        for (int nf = 0; nf < 2; ++nf) { \
          f32x4 a = (f32x4){bias[nf][0] - mb[1], bias[nf][1] - mb[1], bias[nf][2] - mb[1], bias[nf][3] - mb[1]}; \
_Pragma("unroll") \
          for (int ks = 0; ks < 2; ++ks) a = __builtin_amdgcn_mfma_f32_16x16x32_bf16(kfb[nf][ks], qf[1][ks], a, 0, 0, 0); \
          sb[nf] = a; \
        } \
_Pragma("unroll") \
        for (int ef = 0; ef < 4; ++ef) vfa[ef] = *(const bf16x8*)(Vs + (ef * 16 + lr) * 144 + lq * 16); \
        bf16x8 pk[2]; \
        { \
_Pragma("unroll") \
          for (int nf = 0; nf < 2; ++nf) \
_Pragma("unroll") \
            for (int r = 0; r < 4; ++r) { \
              const float p0 = __builtin_amdgcn_exp2f(sa[nf][r]);     \
              const float p1 = __builtin_amdgcn_exp2f(sb[nf][r]); \
              sa[nf][r] = p0; sb[nf][r] = p1; \
            } \
          union { uint32_t u[4]; bf16x8 v; } cvt; \
          cvt.u[0] = pack2(sa[0][0], sa[0][1]); cvt.u[1] = pack2(sa[0][2], sa[0][3]); cvt.u[2] = pack2(sa[1][0], sa[1][1]); cvt.u[3] = pack2(sa[1][2], sa[1][3]); \
          pk[0] = cvt.v; \
          cvt.u[0] = pack2(sb[0][0], sb[0][1]); cvt.u[1] = pack2(sb[0][2], sb[0][3]); cvt.u[2] = pack2(sb[1][0], sb[1][1]); cvt.u[3] = pack2(sb[1][2], sb[1][3]); \
          pk[1] = cvt.v; } \
        __builtin_amdgcn_sched_barrier(0);     \
_Pragma("unroll") \
        for (int ef = 0; ef < 4; ++ef) { \
          oacc[0][ef] = __builtin_amdgcn_mfma_f32_16x16x32_bf16(vfa[ef], pk[0], oacc[0][ef], 0, 0, 0); \
          oacc[1][ef] = __builtin_amdgcn_mfma_f32_16x16x32_bf16(vfa[ef], pk[1], oacc[1][ef], 0, 0, 0); \
          vfb[ef] = *(const bf16x8*)(Vs + ((ef + 4) * 16 + lr) * 144 + lq * 16); \
        } \
        __builtin_amdgcn_sched_barrier(0);     \
_Pragma("unroll") \
        for (int ef = 0; ef < 4; ++ef) { \
          oacc[0][ef + 4] = __builtin_amdgcn_mfma_f32_16x16x32_bf16(vfb[ef], pk[0], oacc[0][ef + 4], 0, 0, 0); \
          oacc[1][ef + 4] = __builtin_amdgcn_mfma_f32_16x16x32_bf16(vfb[ef], pk[1], oacc[1][ef + 4], 0, 0, 0); \
        } \
          \
        oaccl[0] = __builtin_amdgcn_mfma_f32_16x16x32_bf16(onesf, pk[0], oaccl[0], 0, 0, 0); \
        oaccl[1] = __builtin_amdgcn_mfma_f32_16x16x32_bf16(onesf, pk[1], oaccl[1], 0, 0, 0); \
        __builtin_amdgcn_sched_barrier(0); \
      } \
      } while (0)
__device__ __forceinline__ void ph_attn(const bf16_t* Qin, bf16_t* Oout, const bf16_t* Kbp, const bf16_t* Vtp, const float* tabgp, const float* knorm, const float* lq1, const float* lk1,
                        const float* lq2, const float* lk2, const float* subln, int Lidx, char* smc) {
  LANE_IDS
  const int lq = lane >> 4, lr = lane & 15;
  bf16x8 onesf;
#pragma unroll
  for (int e = 0; e < 8; ++e) onesf[e] = (short)0x3F80;
  float* tab = (float*)smc;
  char* stg = smc + 1024;
  float s1 = 0.f, s2 = 0.f, kmax = 0.f;
  for (int d = 0; d < 64; ++d) { s1 += lq1[d] * lk1[d]; s2 += lq2[d] * lk2[d]; kmax = fmaxf(kmax, fabsf(knorm[d])); }
  asm volatile("" : "+s"(Lidx));
  const float lam_init = (Lidx == 2) ? 0.47071302f : 0.55605820f;
  const float lam = expf(s1) - expf(s2) + lam_init;
  const float osc = 1.f - lam_init;
  const float kb = 8.08f * kmax;
  for (int w = blockIdx.x; w < 2048; w += gridDim.x) {
    const int i8 = w & 255, k8 = w >> 8, xcd = i8 & 7, slot = i8 >> 3, jq = slot & 15;
    const int bh = xcd + 8 * (2 * k8 + (slot >> 4));
    const int qb = (k8 & 1) ? (15 - jq) : jq;
    const int b = bh >> 3, h = bh & 7;
    const int q0 = qb * 128, tb = b * 2048;
    const int qpos = q0 + wid * 16 + lr;
    const bf16_t* kbase = Kbp + (size_t)tb * 1024 + h * 128;
    const bf16_t* vbase = Vtp + (size_t)(b * 8 + h) * 128 * 2048;
    const int nkt = 2 * (qb + 1);
    u32x4 kr0[2], vr0[2], kr1[2], vr1[2];
    if (tid < 130) tab[tid] = tabgp[h * 132 + tid];
    bf16x8 qf[2][2];
    float mb[2];
#pragma unroll
    for (int c = 0; c < 2; ++c) {
      float ss = 0.f;
#pragma unroll
      for (int ks = 0; ks < 2; ++ks) {
        const u32x4 qq = *(const u32x4*)(Qin + (size_t)(tb + qpos) * 1024 + h * 128 + c * 64 + ks * 32 + lq * 8);
        union { u32x4 u; bf16x8 v; } cv; cv.u = qq; qf[c][ks] = cv.v;
        ss += bflo(qq.x) * bflo(qq.x) + bfhi(qq.x) * bfhi(qq.x) + bflo(qq.y) * bflo(qq.y) + bfhi(qq.y) * bfhi(qq.y)
            + bflo(qq.z) * bflo(qq.z) + bfhi(qq.z) * bfhi(qq.z) + bflo(qq.w) * bflo(qq.w) + bfhi(qq.w) * bfhi(qq.w);
      }
      ss += __shfl_xor(ss, 16); ss += __shfl_xor(ss, 32);
      mb[c] = sqrtf(ss) * kb;
    }
#define ATT_LOAD(KR, VR, ST) do { _Pragma("unroll") for (int i = 0; i < 2; ++i) { const int v = tid + 512 * i; \
      KR[i] = *(const u32x4*)(kbase + (size_t)((ST) * 64 + (v >> 4)) * 1024 + (v & 15) * 8); \
      VR[i] = *(const u32x4*)(vbase + (size_t)(v >> 3) * 2048 + (ST) * 64 + (v & 7) * 8); } } while (0)
#define ATT_WRITE(KR, VR, BUF) do { char* Kn_ = stg + (BUF) * 35840; _Pragma("unroll") for (int i = 0; i < 2; ++i) { const int v = tid + 512 * i; \
      *(u32x4*)(Kn_ + (v >> 4) * 272 + (v & 15) * 16) = KR[i]; \
      *(u32x4*)(Kn_ + 17408 + (v >> 3) * 144 + (v & 7) * 16) = VR[i]; } } while (0)
    ATT_LOAD(kr0, vr0, 0);
    ATT_LOAD(kr1, vr1, 1);
    ATT_WRITE(kr0, vr0, 0);
    if (nkt > 2) ATT_LOAD(kr0, vr0, 2);
    __syncthreads();
    const float bmax = tab[129];
    const float bfar = tab[128];
    mb[0] += bmax; mb[1] += bmax;
    f32x4 oacc[2][8];
#pragma unroll
    for (int c = 0; c < 2; ++c)
#pragma unroll
      for (int e = 0; e < 8; ++e) oacc[c][e] = (f32x4){0.f, 0.f, 0.f, 0.f};
    f32x4 oaccl[2] = {(f32x4){0.f, 0.f, 0.f, 0.f}, (f32x4){0.f, 0.f, 0.f, 0.f}};
    for (int kt = 0; kt < nkt; kt += 2) {
      ATT_COMPUTE(kt, stg);
      ATT_WRITE(kr1, vr1, 1);
      if (kt + 3 < nkt) ATT_LOAD(kr1, vr1, kt + 3);
      __syncthreads();
      ATT_COMPUTE(kt + 1, (stg + 35840));
      if (kt + 2 < nkt) ATT_WRITE(kr0, vr0, 0);
      if (kt + 4 < nkt) ATT_LOAD(kr0, vr0, kt + 4);
      __syncthreads();
    }
#undef ATT_LOAD
#undef ATT_WRITE
    const float l0 = oaccl[0][0], l1 = oaccl[1][0];
    const float i0 = 1.f / l0, i1 = lam / l1;
    float ss = 0.f;
#pragma unroll
    for (int e = 0; e < 8; ++e) {
      oacc[0][e] = oacc[0][e] * i0 - oacc[1][e] * i1;
      ss += sq4(oacc[0][e]);
    }
    ss += __shfl_xor(ss, 16); ss += __shfl_xor(ss, 32);
    const float rn = rsqrtf(ss * (1.f / 128.f) + EPSF) * osc;
#pragma unroll
    for (int e = 0; e < 8; ++e) {
      const f32x4 gv = *(const f32x4*)(subln + e * 16 + lq * 4);
      const f32x4 o = oacc[0][e] * rn * gv;
      u32x2 wv; wv.x = pack2(o[0], o[1]); wv.y = pack2(o[2], o[3]);
      *(u32x2*)(Oout + (size_t)(tb + qpos) * 1024 + h * 128 + e * 16 + lq * 4) = wv;
    }
  }
}

#define XB_TMO      128
#define XB_XCNT(j)  (256  + 64 * (j))
#define XB_XSUB(j)  (1280 + 64 * (j))
#define XB_XGEN(j)  (2304 + 64 * (j))
#define XB_TOP      3328
#define XB_TOPGEN   3392
#define XCD_BAR_WORDS 3456
#define XB_SPIN_CAP (1u << 18)

__device__ __forceinline__ unsigned xb_ld(unsigned* p)              { return __hip_atomic_load(p, __ATOMIC_RELAXED, __HIP_MEMORY_SCOPE_AGENT); }
__device__ __forceinline__ unsigned xb_add(unsigned* p, unsigned v) { return __hip_atomic_fetch_add(p, v, __ATOMIC_RELAXED, __HIP_MEMORY_SCOPE_AGENT); }
__device__ __forceinline__ unsigned xb_xcc_id() { return (unsigned)__builtin_amdgcn_s_getreg((3 << 11) | 20) & 0xFu; }
#define XB_SPIN(cond, bar) do { unsigned _sp = 0; while (cond) { __builtin_amdgcn_s_sleep(1); \
    if ((++_sp & 255u) == 0u) { if (xb_ld(&(bar)[XB_TMO])) break; if (_sp > XB_SPIN_CAP) { atomicAdd(&(bar)[XB_TMO], 1u); break; } } } } while (0)

struct XcdBarrier {
    unsigned* bar; unsigned x;
    volatile LAS unsigned* st;
};

__device__ __forceinline__ XcdBarrier xcd_barrier_post(unsigned* bar, volatile LAS unsigned* st) {
    XcdBarrier b; b.bar = bar; b.x = xb_xcc_id(); b.st = st;
    if (threadIdx.x == 0) (void)xb_add(&bar[XB_XCNT(b.x)], 1u);
    return b;
}
__device__ __forceinline__ void xcd_barrier_complete(unsigned* bar, unsigned x, unsigned& nloc, unsigned& nx) {
    const unsigned G = gridDim.x * gridDim.y * gridDim.z;
    unsigned sum, cnt, mine, sp = 0u;
    for (;;) {
        sum = 0u; cnt = 0u; mine = 0u;
#pragma unroll
        for (unsigned j = 0; j < 16; ++j) { const unsigned c = xb_ld(&bar[XB_XCNT(j)]); sum += c; cnt += (c > 0u) ? 1u : 0u; mine = (j == x) ? c : mine; }
        if (sum == G) break;
        __builtin_amdgcn_s_sleep(1);
        if ((++sp & 255u) == 0u) { if (xb_ld(&bar[XB_TMO])) break; if (sp > XB_SPIN_CAP) { atomicAdd(&bar[XB_TMO], 1u); break; } }
    }
    nloc = mine > 0u ? mine : 1u; nx = cnt > 0u ? cnt : 1u;
}

__device__ __forceinline__ void xcd_barrier(const XcdBarrier& b) {
    asm volatile("s_waitcnt vmcnt(0)" ::: "memory");
    __syncthreads();
    if (threadIdx.x == 0) {
        unsigned* bar = b.bar;
        __builtin_amdgcn_s_waitcnt(0);
        unsigned nloc = b.st[0], nx = b.st[1];
        if (nloc == 0u) { xcd_barrier_complete(bar, b.x, nloc, nx); b.st[0] = nloc; b.st[1] = nx; }
        const unsigned old = xb_add(&bar[XB_XSUB(b.x)], 1u);
        const unsigned gen = old / nloc;
        if (old + 1u == (gen + 1u) * nloc) {
            __builtin_amdgcn_fence(__ATOMIC_RELEASE, "agent");
            asm volatile("s_waitcnt vmcnt(0)" ::: "memory");
            const unsigned og = xb_add(&bar[XB_TOP], 1u);
            const unsigned tg = og / nx;
            if (og + 1u == (tg + 1u) * nx) xb_add(&bar[XB_TOPGEN], 1u);
            else XB_SPIN(xb_ld(&bar[XB_TOPGEN]) == tg, bar);
            __builtin_amdgcn_fence(__ATOMIC_ACQUIRE, "agent");
            xb_add(&bar[XB_XGEN(b.x)], 1u);
            asm volatile("s_waitcnt vmcnt(0)" ::: "memory");
        } else {
            XB_SPIN(xb_ld(&bar[XB_XGEN(b.x)]) == gen, bar);
            __builtin_amdgcn_fence(__ATOMIC_ACQUIRE, "agent");
            asm volatile("s_waitcnt vmcnt(0)" ::: "memory");
        }
    }
    __syncthreads();
}

#define PHASE_PTRS int z = 0; asm volatile("" : "+s"(z)); char* ws = P.ws + z; const float* const* in = P.in + z; float* x = P.out + z; (void)ws; (void)in; (void)x;
#define WinT ((bf16_t*)(ws + OFF_WIN))
#define WgluT ((bf16_t*)(ws + OFF_WGLU))
#define PT ((bf16_t*)(ws + OFF_PT))
#define YT ((bf16_t*)(ws + OFF_YT))
#define WkvqT ((bf16_t*)(ws + OFF_WKVQ))
#define WoT ((bf16_t*)(ws + OFF_WO))
#define WupT ((bf16_t*)(ws + OFF_WUP))
#define WdnT ((bf16_t*)(ws + OFF_WDN))
#define WgtT ((bf16_t*)(ws + OFF_WGT))
#define WpjT ((bf16_t*)(ws + OFF_WPJ))
#define a16 ((float*)(ws + OFF_SMALL))
#define tabg ((float*)(ws + OFF_SMALL + 65536))
#define SSMC ((float*)(ws + OFF_SMALL + 3584 * 1024))
#define OFF_BAR (OFF_SMALL + 3840 * 1024)
#define ROWSS(v) ((rss_t*)(ws + OFF_SMALL + 131072) + (size_t)(v) * 32768)
#define PBF ((bf16_t*)(ws + OFF_PBF))
#define XBCUR ((bf16_t*)(ws + ((L & 1) ? OFF_XB1 : OFF_XB0)))
#define XBNXT ((bf16_t*)(ws + ((L & 1) ? OFF_XB0 : OFF_XB1)))
#define ug ((bf16_t*)(ws + OFF_UG))
#define S_ ((float*)(ws + OFF_S))
#define Xc ((bf16_t*)(ws + OFF_XC))
#define gy ((bf16_t*)(ws + OFF_GY))
#define Kb ((bf16_t*)(ws + OFF_K))
#define Vt ((bf16_t*)(ws + OFF_VT))
#define QO ((bf16_t*)(ws + OFF_QO))
#define act ((bf16_t*)(ws + OFF_ACT))
#define halo ((float*)(ws + OFF_HALO))
__global__ void __launch_bounds__(NTHR, 2) yoco_mega(Params P) {
  extern __shared__ __attribute__((aligned(1024))) char smraw[];
  float* smf = (float*)smraw;
  volatile LAS unsigned* bst = (volatile LAS unsigned*)(LAS char*)(smraw + 139200);
  if (threadIdx.x == 0) { bst[0] = 0u; bst[1] = 0u; }
  __syncthreads();
  XcdBarrier gbar; gbar.bar = (unsigned*)(P.ws + OFF_BAR); gbar.x = 0; gbar.st = bst;
  if (P.coop) gbar = xcd_barrier_post((unsigned*)(P.ws + OFF_BAR), bst);
  if (P.ph_lo == 0 && blockIdx.x < 64) {
    PHASE_PTRS
    int tid_ = threadIdx.x; asm volatile("" : "+v"(tid_));
    if (tid_ < 128) ssm_consts(in[4], in[5], in[6], SSMC, a16, tid_ >> 6, blockIdx.x, tid_ & 63);
    __threadfence();
  }
  for (int ph = P.ph_lo; ph < P.ph_hi; ++ph) {
    const int L = ph / 10, s = ph % 10;
    const bool isA = L < 2;
    const int j = L - 2;
    const int nrep = ((REPMASK >> s) & 1) ? 2 : 1;
    for (int rep = 0; rep < nrep; ++rep) {
    if ((s == 0 && L == 0) || (s == 9 && L < 3)) {
      PHASE_PTRS
      const int LP = (s == 0) ? 0 : L + 1;
      const bool pA = LP < 2; const int jp = LP - 2;
      if (s == 9) ph_ple(XBCUR, ROWSS(3 * L + 2), WgtT, x, XBNXT, ROWSS(3 * L + 3), false, smraw);
      if (LP == 0) prep_x(in[0], (bf16_t*)(ws + OFF_XB0), ROWSS(0));
      prep_p(in[1] + (size_t)LP * 32768 * 256, PBF);
      if (pA) prep_ssm(SSMC + (size_t)LP * 16384, in[7] + (size_t)LP * 65536, in[8] + (size_t)LP * 65536,
                       in[9] + (size_t)LP * 65536, in[10] + (size_t)LP * 65536, PT, YT, smf);
      else if (jp == 0) prep_bias(in[25], tabg);
#pragma unroll 1
      for (int mi = 0; mi < 7; ++mi) {
        const float* src = nullptr; const float* gain = nullptr; bf16_t* dst = nullptr; int K = 1024, N = 1024, Nsub = 1024, mode = 0;
        if (mi == 0) { src = in[27] + (size_t)LP * 1024 * 5632; N = 5632; Nsub = 5632; dst = WupT; gain = in[26] + LP * 1024; mode = 2; }
        else if (mi == 1) { src = in[30] + (size_t)LP * 2816 * 1024; K = 2816; dst = WdnT; mode = 3; }
        else if (mi == 2) { if (LP != 0) continue; src = in[32]; dst = WgtT; gain = in[31]; mode = 3; }
        else if (mi == 3) { src = in[33] + (size_t)LP * 256 * 1024; K = 256; dst = WpjT; mode = 3; }
        else if (pA) {
          if (mi == 4) { src = in[3] + (size_t)LP * 1024 * 1024; dst = WinT; gain = in[2] + LP * 1024; mode = 3; }
          else if (mi == 5) { src = in[12] + (size_t)LP * 1024 * 2048; N = 2048; Nsub = 2048; dst = WgluT; mode = 1; }
          else continue;
        } else {
          if (mi == 4) { src = in[24] + (size_t)jp * 1024 * 1024; dst = WoT; mode = 3; }
          else if (mi == 5) { src = in[17] + (size_t)jp * 1024 * 1024; dst = WkvqT + (jp == 0 ? (size_t)2048 * 1024 : 0); gain = in[16] + jp * 1024; mode = 3; }
          else if (jp == 0) { src = in[14]; N = 2048; Nsub = 2048; dst = WkvqT; gain = in[13]; mode = 3; }
          else continue;
        }
        prep_mat(src, K, N, Nsub, dst, gain, mode, smf);
      }
    } else if (s == 1) {
      PHASE_PTRS
      if (isA) ph_win(XBCUR, ROWSS(3 * L), WinT, ug, smraw);
      else ph_kvq(XBCUR, ROWSS(3 * L), WkvqT, j == 0 ? 12 : 4, j == 0 ? 0 : 2048, in[15], in[18] + j * 64, Kb, Vt, QO, smraw);
      if (L >= 1) prep_mat(in[32] + (size_t)L * 1024 * 1024, 1024, 1024, 1024, WgtT, in[31] + L * 1024, 3, smf);
    } else if (s == 2) {
      PHASE_PTRS
      if (isA) ph_ssm_fused(ug, PT, YT, a16 + (size_t)L * 8192, Xc, in[11] + L * 1024, gy, smraw);
      else ph_attn(QO, (rep + 1 < nrep) ? (bf16_t*)(ws + 400 * MIB) : QO, Kb, Vt, tabg, in[15], in[19] + j * 64, in[20] + j * 64, in[21] + j * 64, in[22] + j * 64, in[23] + j * 128,
                   L, smraw);
    } else if (s == 3) {
      PHASE_PTRS
      ;
    } else if (s == 4) {
      PHASE_PTRS
      ;
    } else if (s == 5) {
      PHASE_PTRS
      if (isA) ph_wglu(gy, WgluT, XBCUR, ROWSS(3 * L + 1), smraw);
    } else if (s == 6) {
      PHASE_PTRS
      ph_halo_proj(XBCUR, ROWSS(3 * L + 1), WupT, halo, PBF, WpjT, XBNXT, smraw);
      ph_proj(PBF, WpjT, XBNXT, smraw);
    } else if (s == 7) {
      PHASE_PTRS
      ph_up(XBCUR, ROWSS(3 * L + 1), WupT, halo, in[28] + (size_t)L * 3 * 5632, in[29] + (size_t)L * 5632, act, smraw);
    } else if (s == 9) {
      PHASE_PTRS
      ph_ple(XBCUR, ROWSS(3 * L + 2), WgtT, x, XBNXT, ROWSS(3 * L + 3), true, smraw);
    }
    if (nrep > 1 && rep == 0 && P.coop) xcd_barrier(gbar);
    }
    if ((s == 3 && !isA) || s == 8) {
      PHASE_PTRS
      const bool dn = s == 8;
      ph_resid(dn ? act : QO, dn ? 2816 : 1024, dn ? WdnT : WoT, XBCUR, ROWSS(3 * L + (dn ? 2 : 1)), smraw);
    }
    if (P.coop && ph + 1 < P.ph_hi && !(!isA && (s == 4 || s == 5)) && !(isA && (s == 3 || s == 4)) && !(s == 0 && L > 0)) {
      if (P.coop == 2) cg::this_grid().sync();
      xcd_barrier(gbar);
      if (REPMASK & 1024) xcd_barrier(gbar);
    }
  }
}

extern "C" void kernel_launch(void* const* d_in, const int* in_sizes, int n_in, void* d_out, int out_size, void* d_ws, size_t ws_size,
                              hipStream_t stream) {
  static int grid_blocks = 0;
  if (!grid_blocks) {
    int dev = 0, cus = 0, per_cu = 0;
    (void)hipGetDevice(&dev);
    (void)hipDeviceGetAttribute(&cus, hipDeviceAttributeMultiprocessorCount, dev);
    if (hipFuncSetAttribute((const void*)yoco_mega, hipFuncAttributeMaxDynamicSharedMemorySize, LDS_BYTES) != hipSuccess)
      fprintf(stderr, "hipFuncSetAttribute(MaxDynamicSharedMemorySize) failed\n");
    (void)hipOccupancyMaxActiveBlocksPerMultiprocessor(&per_cu, (const void*)yoco_mega, NTHR, LDS_BYTES);
    if (per_cu < 1) { fprintf(stderr, "occupancy query says %d blocks/CU\n", per_cu); per_cu = 1; }
    if (per_cu > 1) per_cu = 1;
    grid_blocks = cus * per_cu;
    if (ws_size < WS_NEED) fprintf(stderr, "workspace too small: %zu < %llu\n", ws_size, (unsigned long long)WS_NEED);
  }
  Params P;
  memset(&P, 0, sizeof(P));
  for (int i = 0; i < 34; ++i) P.in[i] = (const float*)d_in[i];
  P.out = (float*)d_out;
  P.ws = (char*)d_ws;
#if MK_SINGLE
  P.ph_lo = 0; P.ph_hi = 40; P.coop = 1;
  (void)hipMemsetAsync((char*)d_ws + OFF_BAR, 0, XCD_BAR_WORDS * 4, stream);
  void* args[] = {&P};
  hipError_t e = hipLaunchCooperativeKernel((void*)yoco_mega, dim3(grid_blocks), dim3(NTHR), args, LDS_BYTES, stream);
  if (e != hipSuccess) fprintf(stderr, "cooperative launch failed: %s (grid %d)\n", hipGetErrorString(e), grid_blocks);
#else
  for (int ph = 0; ph < 40; ++ph) {
    const int L = ph / 10, s = ph % 10;
    if (L >= 2 && (s == 4 || s == 5)) continue;
    P.ph_lo = ph; P.ph_hi = ph + 1; P.coop = 0;
    hipLaunchKernelGGL(yoco_mega, dim3(grid_blocks), dim3(NTHR), LDS_BYTES, stream, P);
  }
#endif
}
```
